# Optimizing an MI355X kernel written in HIP

```python
import jax, jax.numpy as jnp
from jax import lax
import numpy as np

D_MODEL = 2048
BATCH = 4
SEQ = 2048
DEPTH = 2

POOL_WINDOWS = (2, 4, 8, 16)
POOL_GROUP = D_MODEL // 8
POOL_WIDTH = POOL_GROUP * len(POOL_WINDOWS)
ATTN_HEADS = 16
ATTN_KV_HEADS = 4
ATTN_HEAD_DIM = 64
ATTN_WINDOW = 128
ATTN_BLOCK = 128
Q_WIDTH = ATTN_HEADS * ATTN_HEAD_DIM
KV_WIDTH = ATTN_KV_HEADS * ATTN_HEAD_DIM
RET_HEADS = 4
RET_KEY_DIM = 256
RET_VALUE_DIM = 512
RET_CHUNK = 128
RQK_WIDTH = RET_HEADS * RET_KEY_DIM
RV_WIDTH = RET_HEADS * RET_VALUE_DIM
FFN_HIDDEN = 5632
RMS_EPS = 1e-6
N_BRANCHES = 3

IN_SPLITS = (POOL_WIDTH, Q_WIDTH, KV_WIDTH, KV_WIDTH, RQK_WIDTH, RQK_WIDTH, RV_WIDTH, RV_WIDTH)
IN_WIDTH = int(sum(IN_SPLITS))
IN_OFFSETS = tuple(int(o) for o in np.cumsum(IN_SPLITS)[:-1])

kernel_name = "hybrid_gated_pool_swa_retention_macaron"


def rms_norm(x, g):
    xf = x.astype(jnp.float32)
    y = xf * lax.rsqrt(jnp.mean(xf * xf, axis=-1, keepdims=True) + RMS_EPS)
    return (y * g.astype(jnp.float32)).astype(x.dtype)


def swiglu(x, w_up, w_down):
    g, u = jnp.split(x @ w_up, 2, axis=-1)
    return (jax.nn.silu(g) * u) @ w_down


def pool_mixer(xp, w_group, scale):
    B, S, _ = xp.shape
    xf = xp.astype(jnp.float32)
    cs = jnp.concatenate([jnp.zeros((B, 1, POOL_WIDTH), jnp.float32), jnp.cumsum(xf, axis=1)], axis=1)
    t = jnp.arange(S)
    groups = []
    for gi, w in enumerate(POOL_WINDOWS):
        sl = slice(gi * POOL_GROUP, (gi + 1) * POOL_GROUP)
        start = jnp.maximum(t + 1 - w, 0)
        window_sum = cs[:, 1:, sl] - cs[:, start, sl]
        count = (t + 1 - start).astype(jnp.float32)[None, :, None]
        groups.append(window_sum / count - xf[:, :, sl])
    pooled = jnp.stack(groups, axis=2).astype(xp.dtype)
    mixed = jnp.einsum('bsgc,gcd->bsgd', pooled, w_group)
    return mixed.reshape(B, S, POOL_WIDTH) * scale


def sliding_window_attention(q, k, v, sinks):
    B, S, _ = q.shape
    NB = S // ATTN_BLOCK
    G = ATTN_HEADS // ATTN_KV_HEADS
    qb = q.reshape(B, NB, ATTN_BLOCK, ATTN_KV_HEADS, G, ATTN_HEAD_DIM)
    kb = k.reshape(B, NB, ATTN_BLOCK, ATTN_KV_HEADS, ATTN_HEAD_DIM)
    vb = v.reshape(B, NB, ATTN_BLOCK, ATTN_KV_HEADS, ATTN_HEAD_DIM)

    def with_prev(xb):
        prev = jnp.concatenate([jnp.zeros_like(xb[:, :1]), xb[:, :-1]], axis=1)
        return jnp.concatenate([prev, xb], axis=2)

    kk, vv = with_prev(kb), with_prev(vb)
    scores = jnp.einsum('bnqhgd,bnkhd->bhgnqk', qb, kk).astype(jnp.float32) * (ATTN_HEAD_DIM ** -0.5)
    qi = jnp.arange(ATTN_BLOCK)[:, None]
    ki = jnp.arange(2 * ATTN_BLOCK)[None, :]
    dist = qi + ATTN_BLOCK - ki
    key_pos = jnp.arange(NB)[:, None, None] * ATTN_BLOCK - ATTN_BLOCK + ki[None]
    valid = (dist >= 0) & (dist < ATTN_WINDOW) & (key_pos >= 0)
    slopes = jnp.exp2(-8.0 * jnp.arange(1, ATTN_HEADS + 1, dtype=jnp.float32) / ATTN_HEADS)
    alibi = -slopes.reshape(ATTN_KV_HEADS, G)[:, :, None, None, None] * dist.astype(jnp.float32)
    scores = jnp.where(valid, scores + alibi, -jnp.inf)
    sink = sinks.astype(jnp.float32).reshape(ATTN_KV_HEADS, G)[:, :, None, None, None]
    m = jnp.maximum(jnp.max(scores, axis=-1, keepdims=True), sink)
    p = jnp.exp(scores - m)
    p = p / (jnp.sum(p, axis=-1, keepdims=True) + jnp.exp(sink - m))
    out = jnp.einsum('bhgnqk,bnkhd->bnqhgd', p.astype(v.dtype), vv)
    return out.reshape(B, S, Q_WIDTH)


def retention(q, k, v):
    B, S = q.shape[0], q.shape[1]
    NC = S // RET_CHUNK
    log_g = jnp.log(1.0 - jnp.exp2(-5.0 - jnp.arange(RET_HEADS, dtype=jnp.float32)))
    k = k * (RET_KEY_DIM ** -0.5)

    def chunks(a):
        return a.reshape(B, NC, RET_CHUNK, RET_HEADS, a.shape[-1]).transpose(1, 0, 3, 2, 4)

    qc, kc, vc = chunks(q), chunks(k), chunks(v)
    pos = jnp.arange(RET_CHUNK, dtype=jnp.float32)
    diff = pos[:, None] - pos[None, :]
    intra = jnp.where(diff >= 0, jnp.exp(log_g[:, None, None] * jnp.maximum(diff, 0.0)), 0.0)
    q_decay = jnp.exp(log_g[:, None] * (pos + 1.0))[..., None]
    k_decay = jnp.exp(log_g[:, None] * (RET_CHUNK - 1.0 - pos))[..., None]
    chunk_decay = jnp.exp(log_g * RET_CHUNK)[:, None, None]

    def step(state, xs):
        qi, ki, vi = xs
        inner = jnp.einsum('bhid,bhjd->bhij', qi, ki) * intra
        o = jnp.einsum('bhij,bhjv->bhiv', inner, vi) + jnp.einsum('bhid,bhdv->bhiv', qi * q_decay, state)
        state = state * chunk_decay + jnp.einsum('bhjd,bhjv->bhdv', ki * k_decay, vi)
        return state, o

    state0 = jnp.zeros((B, RET_HEADS, RET_KEY_DIM, RET_VALUE_DIM), jnp.float32)
    _, o = lax.scan(step, state0, (qc, kc, vc))
    return o.transpose(1, 0, 3, 2, 4).reshape(B, S, RET_HEADS, RET_VALUE_DIM)


def hybrid_mixer(u, w_in, pool_w, pool_scale, attn_sinks, ret_norm,
                 w_pool_out, w_attn_out, w_ret_out, w_gate, w_out):
    B, S, _ = u.shape
    xp, q, k, v, rq, rk, rv, rg = jnp.split(u @ w_in, IN_OFFSETS, axis=-1)
    pool_out = pool_mixer(xp, pool_w, pool_scale) @ w_pool_out
    attn_out = sliding_window_attention(q, k, v, attn_sinks) @ w_attn_out
    f32 = jnp.float32
    o = retention(rq.reshape(B, S, RET_HEADS, RET_KEY_DIM).astype(f32),
                  rk.reshape(B, S, RET_HEADS, RET_KEY_DIM).astype(f32),
                  rv.reshape(B, S, RET_HEADS, RET_VALUE_DIM).astype(f32))
    o = o * lax.rsqrt(jnp.mean(o * o, axis=-1, keepdims=True) + RMS_EPS)
    o = o.reshape(B, S, RV_WIDTH) * ret_norm.astype(f32)
    ret_out = (jax.nn.silu(rg.astype(f32)) * o).astype(u.dtype) @ w_ret_out
    g_pool, g_attn, g_ret = jnp.split(jax.nn.sigmoid((u @ w_gate).astype(f32)).astype(u.dtype), N_BRANCHES, axis=-1)
    merged = g_pool * pool_out + g_attn * attn_out + g_ret * ret_out
    return merged @ w_out


def setup_inputs(seed: int = 0) -> dict:
    key = jax.random.key(seed)
    ks = jax.random.split(key, 32)
    f32 = jnp.float32

    def dense(k, shape, fan_in):
        return jax.random.normal(k, shape, f32) * (fan_in ** -0.5)

    def gain(k, shape):
        return 1.0 + 0.05 * jax.random.normal(k, shape, f32)

    L, D, F = DEPTH, D_MODEL, FFN_HIDDEN
    return {
        "x": jax.random.normal(ks[0], (BATCH, SEQ, D), f32),
        "ffn1_pre": gain(ks[1], (L, D)),
        "ffn1_up": dense(ks[2], (L, D, 2 * F), D),
        "ffn1_down": dense(ks[3], (L, F, D), F),
        "ffn1_post": gain(ks[4], (L, D)),
        "mix_pre": gain(ks[5], (L, D)),
        "w_in": dense(ks[6], (L, D, IN_WIDTH), D),
        "pool_w": dense(ks[7], (L, len(POOL_WINDOWS), POOL_GROUP, POOL_GROUP), POOL_GROUP),
        "pool_scale": gain(ks[8], (L, POOL_WIDTH)),
        "attn_sinks": jax.random.normal(ks[9], (L, ATTN_HEADS), f32),
        "ret_norm": gain(ks[10], (L, RV_WIDTH)),
        "w_pool_out": dense(ks[11], (L, POOL_WIDTH, D), POOL_WIDTH),
        "w_attn_out": dense(ks[12], (L, Q_WIDTH, D), Q_WIDTH),
        "w_ret_out": dense(ks[13], (L, RV_WIDTH, D), RV_WIDTH),
        "w_gate": dense(ks[14], (L, D, N_BRANCHES * D), D),
        "w_out": dense(ks[15], (L, D, D), D),
        "mix_post": gain(ks[16], (L, D)),
        "ffn2_pre": gain(ks[17], (L, D)),
        "ffn2_up": dense(ks[18], (L, D, 2 * F), D),
        "ffn2_down": dense(ks[19], (L, F, D), F),
        "ffn2_post": gain(ks[20], (L, D)),
    }


def reference(x, ffn1_pre, ffn1_up, ffn1_down, ffn1_post, mix_pre, w_in, pool_w, pool_scale,
              attn_sinks, ret_norm, w_pool_out, w_attn_out, w_ret_out, w_gate, w_out, mix_post,
              ffn2_pre, ffn2_up, ffn2_down, ffn2_post):
    h = x
    for l in range(DEPTH):
        h = h + 0.5 * rms_norm(swiglu(rms_norm(h, ffn1_pre[l]), ffn1_up[l], ffn1_down[l]), ffn1_post[l])
        mix = hybrid_mixer(rms_norm(h, mix_pre[l]), w_in[l], pool_w[l], pool_scale[l], attn_sinks[l],
                           ret_norm[l], w_pool_out[l], w_attn_out[l], w_ret_out[l], w_gate[l], w_out[l])
        h = h + rms_norm(mix, mix_post[l])
        h = h + 0.5 * rms_norm(swiglu(rms_norm(h, ffn2_pre[l]), ffn2_up[l], ffn2_down[l]), ffn2_post[l])
    return h
```

```cpp
#include <hip/hip_runtime.h>
#include <hip/hip_cooperative_groups.h>
#include <cstdio>
#include <cstdint>
namespace cg = cooperative_groups;

#ifndef MK_COOP
#define MK_COOP 1
#endif
#ifndef REP
#define REP 0
#endif

#define LAS __attribute__((address_space(3)))
typedef unsigned short bf16_t;
typedef short bf16x8 __attribute__((ext_vector_type(8)));
typedef float f32x4 __attribute__((ext_vector_type(4)));
typedef float f32x16 __attribute__((ext_vector_type(16)));
typedef unsigned u32x4 __attribute__((ext_vector_type(4)));
typedef unsigned u32x2 __attribute__((ext_vector_type(2)));

constexpr int MTOK = 8192, DM = 2048, FF = 5632, SEQ = 2048;
constexpr int NIN = 14848;
constexpr float EPS = 1e-6f;
constexpr int NPHASE = 27;

constexpr size_t MiB = (size_t)1 << 20;
constexpr size_t WS_WUP1 = 0, WS_WDN1 = 44 * MiB, WS_WUP2 = 66 * MiB, WS_WDN2 = 110 * MiB, WS_WIN = 132 * MiB, WS_WCAT = 190 * MiB,
                 WS_WOUT = 206 * MiB, WS_WPOT = 214 * MiB, WS_WPG = 218 * MiB, WS_HBF = 220 * MiB, WS_Y = 252 * MiB, WS_SSQ = 316 * MiB,
                 WS_RINV = 317 * MiB, WS_SSQO = 318 * MiB, WS_BAR = 319 * MiB, WS_ACT = 320 * MiB, WS_G = 320 * MiB, WS_XP = 416 * MiB, WS_Q = 432 * MiB,
                 WS_KB = 448 * MiB, WS_VT = 452 * MiB, WS_RQ = 456 * MiB, WS_RK = 472 * MiB, WS_RA = 488 * MiB, WS_RKT = 520 * MiB,
                 WS_RB = 536 * MiB, WS_SG = 600 * MiB, WS_DS = 632 * MiB, WS_MF = 632 * MiB, WS_ACAT = 696 * MiB, WS_MB = 760 * MiB,
                 WS_END = 792 * MiB;

constexpr int LDS_BYTES = 147456;

__device__ __forceinline__ unsigned cvt_pk_bf16(float lo, float hi) { unsigned r; asm volatile("v_cvt_pk_bf16_f32 %0, %1, %2" : "=v"(r) : "v"(lo), "v"(hi)); return r; }
__device__ __forceinline__ float bf_lo(unsigned w) { return __uint_as_float(w << 16); }
__device__ __forceinline__ float bf_hi(unsigned w) { return __uint_as_float(w & 0xffff0000u); }
__device__ __forceinline__ float fast_sigmoid(float x) { return __builtin_amdgcn_rcpf(1.0f + __builtin_amdgcn_exp2f(-1.4426950409f * x)); }
__device__ __forceinline__ float fast_silu(float x) { return x * fast_sigmoid(x); }
__device__ __forceinline__ float ret_lg(int h) { return log2f(1.0f - exp2f(-5.0f - (float)h)); }

namespace pg8 {
constexpr int BM = 256, BK = 64, HALF = 128, HTB = HALF * BK * 2, STAGE_BYTES = 8 * HTB, NXCD = 8, WGM = 8;
__device__ __forceinline__ int lds_byte(int r, int c) { const int st = (r >> 4) * 2 + (c >> 5), rr = r & 15, cc = c & 31, ob = rr * 64 + cc * 2; return st * 1024 + (ob ^ (((ob >> 9) & 1) << 5)); }
__device__ __forceinline__ void stage_rc(int b, int& R, int& C) { const int st = b / 1024, sb = b % 1024, swz = sb ^ (((sb >> 9) & 1) << 5); R = (st >> 1) * 16 + swz / 64; C = (st & 1) * 32 + (swz % 64) / 2; }
__device__ __forceinline__ int perm32(int rho) { const int n = rho >> 4, i = rho & 15; return 8 * (i >> 2) + 4 * n + (i & 3); }

struct Unit { size_t aoff, boff; int nt, pm, pn, aux, first; };
struct Gemm { const bf16_t* A; const bf16_t* Bt; int lda, ldb; };

__device__ __forceinline__ void tile_map(int L, int nM, int nN, int& pm, int& pn) {
    const int nwg = nM * nN; int wgid = L;
    { const int q = nwg / NXCD, r = nwg % NXCD, xcd = wgid % NXCD, off = wgid / NXCD; wgid = (xcd < r ? xcd * (q + 1) : r * (q + 1) + (xcd - r) * q) + off; }
    const int nig = WGM * nN, gid = wgid / nig, fm = gid * WGM, gsz = (nM - fm) < WGM ? (nM - fm) : WGM;
    pm = fm + ((wgid % nig) % gsz); pn = (wgid % nig) / gsz;
}

template <class Epi, class Sched>
__device__ __forceinline__ void gemm_phase(LAS unsigned char* lds, const Gemm g, const Sched& S, const Epi& E, const int tid) {
    const int wid = __builtin_amdgcn_readfirstlane(tid >> 6), lane = tid & 63, wr = wid >> 2, wc = wid & 3, fr = lane & 15, fq = lane >> 4;
    unsigned voffA, voffB;
    { int R, C; stage_rc(tid * 16, R, C); const int Rb = Epi::PERM ? ((R & ~31) + perm32(R & 31)) : R;
        voffA = (unsigned)(R * g.lda + C) * 2u; voffB = (unsigned)(Rb * g.ldb + C) * 2u; }
    const size_t d64A = (size_t)64 * g.lda * 2, d64B = (size_t)64 * g.ldb * 2;
    const size_t kstep = (size_t)(BK * 2);
    const size_t hstepA = (size_t)HALF * g.lda * 2, hstepB = (size_t)HALF * g.ldb * 2;
    const unsigned ldsw = (unsigned)wid * 1024u;
    const int aoff = lds_byte(wr * 64 + fr, fq * 8), boff = lds_byte(wc * 32 + fr, fq * 8);
#define d64offA d64A
#define d64offB d64B
#define PG8_SA(b, h) (((b) * 2 + (h)) * HTB)
#define PG8_SB(b, h) ((4 + (b) * 2 + (h)) * HTB)
#define PG8_STAGE(bufoff, gbase, voff) do { _Pragma("unroll") for (int _i = 0; _i < 2; ++_i) \
        __builtin_amdgcn_global_load_lds((const unsigned*)((const char*)(gbase) + (size_t)_i * d64##voff + v##voff), (LAS unsigned*)(lds + (bufoff) + ldsw + _i * 8192), 16, 0, 0); } while (0)
#define PG8_LDA(dst, b, h) do { _Pragma("unroll") for (int m = 0; m < 4; ++m) _Pragma("unroll") for (int k = 0; k < 2; ++k) dst[m][k] = *(const LAS bf16x8*)(lds + PG8_SA(b, h) + aoff + m * 2048 + k * 1024); } while (0)
#define PG8_LDB(dst, b, h) do { _Pragma("unroll") for (int n = 0; n < 2; ++n) _Pragma("unroll") for (int k = 0; k < 2; ++k) dst[n][k] = *(const LAS bf16x8*)(lds + PG8_SB(b, h) + boff + n * 2048 + k * 1024); } while (0)
#define PG8_MMA(ai, bj, At, Bt) do { __builtin_amdgcn_s_setprio(1); _Pragma("unroll") for (int m = 0; m < 4; ++m) _Pragma("unroll") for (int n = 0; n < 2; ++n) _Pragma("unroll") for (int k = 0; k < 2; ++k) \
        acc[ai][bj][m][n] = __builtin_amdgcn_mfma_f32_16x16x32_bf16(Bt[n][k], At[m][k], acc[ai][bj][m][n], 0, 0, 0); __builtin_amdgcn_s_setprio(0); } while (0)
#define PG8_WAIT_V(n) asm volatile("s_waitcnt vmcnt(" #n ")" ::: "memory")
#define PG8_WAIT_L(n) asm volatile("s_waitcnt lgkmcnt(" #n ")" ::: "memory")
#define PG8_BAR __builtin_amdgcn_s_barrier()
#define PG8_SCHED __builtin_amdgcn_sched_barrier(0)
    Unit cur, nxt; int ui = 0;
    if (!S.next(0, cur)) return;
    f32x4 acc[2][2][4][2];
#pragma unroll
    for (int a = 0; a < 2; ++a)
#pragma unroll
        for (int b = 0; b < 2; ++b)
#pragma unroll
            for (int m = 0; m < 4; ++m)
#pragma unroll
                for (int n = 0; n < 2; ++n) acc[a][b][m][n] = (f32x4){0.f, 0.f, 0.f, 0.f};
    bf16x8 At[4][2], B0[2][2], B1[2][2];
    const char* cA = (const char*)g.A + cur.aoff; const char* cB = (const char*)g.Bt + cur.boff;
    PG8_STAGE(PG8_SB(0, 0), cB, offB); PG8_STAGE(PG8_SB(0, 1), cB + hstepB, offB); PG8_STAGE(PG8_SA(0, 0), cA, offA); PG8_STAGE(PG8_SA(0, 1), cA + hstepA, offA);
    if (wr == 1) PG8_BAR;
    PG8_WAIT_V(2); PG8_BAR;
    PG8_STAGE(PG8_SB(1, 0), cB + kstep, offB); PG8_STAGE(PG8_SA(1, 0), cA + kstep, offA); PG8_STAGE(PG8_SB(1, 1), cB + hstepB + kstep, offB);
    PG8_WAIT_V(6); PG8_BAR;
    for (;;) {
        const bool has_next = S.next(ui + 1, nxt);
        const char* nA = has_next ? (const char*)g.A + nxt.aoff : cA; const char* nB = has_next ? (const char*)g.Bt + nxt.boff : cB;
        int nt = cur.nt; asm volatile("" : "+s"(nt));
#pragma nounroll
        for (int t = 0; t < nt; t += 2) {
            const bool last = (t == nt - 2);
            const char* a1 = cA + (size_t)(t + 1) * kstep;
            const char* a2 = last ? nA : cA + (size_t)(t + 2) * kstep; const char* b2 = last ? nB : cB + (size_t)(t + 2) * kstep;
            const char* a3 = a2 + kstep; const char* b3 = b2 + kstep;
            PG8_LDB(B0, 0, 0); PG8_LDB(B1, 0, 1); PG8_SCHED; PG8_LDA(At, 0, 0); PG8_STAGE(PG8_SA(1, 1), a1 + hstepA, offA);
            PG8_WAIT_V(8); PG8_WAIT_L(0); PG8_BAR; PG8_MMA(0, 0, At, B0); PG8_MMA(0, 1, At, B1); PG8_BAR; PG8_SCHED;
            PG8_LDA(At, 0, 1); PG8_STAGE(PG8_SB(0, 0), b2, offB); PG8_STAGE(PG8_SB(0, 1), b2 + hstepB, offB); PG8_STAGE(PG8_SA(0, 0), a2, offA);
            PG8_WAIT_V(8); PG8_WAIT_L(0); PG8_BAR; PG8_MMA(1, 0, At, B0); PG8_MMA(1, 1, At, B1); PG8_BAR; PG8_SCHED;
            PG8_LDB(B0, 1, 0); PG8_LDB(B1, 1, 1); PG8_SCHED; PG8_LDA(At, 1, 0); PG8_STAGE(PG8_SA(0, 1), a2 + hstepA, offA);
            PG8_WAIT_V(8); PG8_WAIT_L(0); PG8_BAR; PG8_MMA(0, 0, At, B0); PG8_MMA(0, 1, At, B1); PG8_BAR; PG8_SCHED;
            PG8_LDA(At, 1, 1); PG8_STAGE(PG8_SB(1, 0), b3, offB); PG8_STAGE(PG8_SB(1, 1), b3 + hstepB, offB); PG8_STAGE(PG8_SA(1, 0), a3, offA);
            PG8_WAIT_V(8); PG8_WAIT_L(0); PG8_BAR; PG8_MMA(1, 0, At, B0); PG8_MMA(1, 1, At, B1); PG8_BAR; PG8_SCHED;
        }
        if (wr == 0) PG8_BAR;
        { int l2; asm volatile("v_mbcnt_lo_u32_b32 %0, -1, 0\n\tv_mbcnt_hi_u32_b32 %0, -1, %0" : "=v"(l2));
          E(acc, cur, wr, wc, l2 & 15, l2 >> 4); }
        if (!has_next) break;
        if (nxt.first) {
#pragma unroll
        for (int a = 0; a < 2; ++a)
#pragma unroll
            for (int b = 0; b < 2; ++b)
#pragma unroll
                for (int m = 0; m < 4; ++m)
#pragma unroll
                    for (int n = 0; n < 2; ++n) acc[a][b][m][n] = (f32x4){0.f, 0.f, 0.f, 0.f};
        }
        cur = nxt; cA = nA; cB = nB; ++ui;
        if (wr == 1) PG8_BAR;
    }
    PG8_WAIT_V(0);
    PG8_BAR;
#undef d64offA
#undef d64offB
#undef PG8_SA
#undef PG8_SB
#undef PG8_STAGE
#undef PG8_LDA
#undef PG8_LDB
#undef PG8_MMA
#undef PG8_WAIT_V
#undef PG8_WAIT_L
#undef PG8_BAR
#undef PG8_SCHED
}

struct SchedStd {
    int nM, nN, G, c, lda, ldb, nt;
    __device__ __forceinline__ bool next(int i, Unit& u) const {
        const long L = (long)i * G + c; if (L >= (long)nM * nN) return false;
        int pm, pn; tile_map((int)L, nM, nN, pm, pn);
        u.first = 1; u.pm = pm; u.pn = pn; u.aux = 0; u.nt = nt; u.aoff = (size_t)pm * 256 * lda * 2; u.boff = (size_t)pn * 256 * ldb * 2; return true;
    }
};
struct SchedPre {
    int G, c;
    __device__ __forceinline__ bool next(int i, Unit& u) const {
        const int L = i * G + c; if (L >= 32) return false;
        const int pm = L & 7, gi = L >> 3;
        u.first = 1; u.pm = pm; u.pn = gi; u.aux = 0; u.nt = 4; u.aoff = ((size_t)pm * 256 * 1024 + gi * 256) * 2; u.boff = (size_t)gi * 65536 * 2; return true;
    }
};
struct SchedInner {
    int G, c;
    __device__ __forceinline__ bool next(int i, Unit& u) const {
        int L = i * G + c; if (L >= 128) return false;
        if (G == 224) L = (((c & 7) >> 1) << 5) | ((c & 1) << 4) | (c >> 3);
        const int h = L & 3, pm = L >> 2;
        u.first = 1; u.pm = pm; u.pn = 0; u.aux = h; u.nt = 4; u.aoff = ((size_t)pm * 256 * 1024 + h * 256) * 2; u.boff = u.aoff; return true;
    }
};
struct SchedChain {
    int c;
    __device__ __forceinline__ bool next(int i, Unit& u) const {
        if (i >= 7) return false;
        const int cq = (((c & 7) >> 1) << 3) | ((c & 1) << 2) | (c >> 3);
        const int dvh = cq & 1, bh = cq >> 1, b = bh >> 2, h = bh & 3, cc = i;
        u.first = (i == 0); u.pm = (bh * 8 + cc) * 2 + dvh; u.pn = cc; u.aux = h; u.nt = 4;
        u.aoff = ((size_t)((bh * 8 + cc) * 512 + dvh * 256) * 512) * 2;
        u.boff = ((size_t)((b * 8 + cc) * 256) * 1024 + h * 256) * 2; return true;
    }
};
struct SchedO {
    int G, c;
    __device__ __forceinline__ bool next(int i, Unit& u) const {
        int L = i * G + c; if (L >= 256) return false;
        if (G == 256) L = ((c & 6) << 5) | ((c & 1) << 5) | (c >> 3);
        const int dvh = L & 1, h = (L >> 1) & 3, cc = (L >> 3) & 7, b = L >> 6;
        u.first = 1; u.pm = b * 8 + cc; u.pn = dvh; u.aux = h; u.nt = cc == 0 ? 4 : 8;
        u.aoff = ((size_t)(b * 8 + cc) * 256 * 2048 + h * 512) * 2;
        u.boff = ((size_t)(((b * 4 + h) * 8 + cc) * 512 + dvh * 256) * 512) * 2; return true;
    }
};
struct SchedCat {
    int G, c;
    __device__ __forceinline__ bool next(int i, Unit& u) const {
        const int T = (i / 6) * G + c, u6 = i % 6; if (T >= 256) return false;
        int pm, pn; tile_map(T, 32, 8, pm, pn);
        const int k0 = u6 == 0 ? 0 : (u6 == 1 ? 1024 : 2048 + (u6 - 2) * 512);
        u.first = (u6 == 0); u.pm = pm; u.pn = pn; u.aux = u6; u.nt = u6 < 2 ? 16 : 8;
        u.aoff = ((size_t)pm * 256 * 4096 + k0) * 2; u.boff = ((size_t)pn * 256 * 4096 + k0) * 2; return true;
    }
};

typedef const f32x4 (&AccRef)[2][2][4][2];

struct EpiSwiglu {
    static constexpr bool PERM = true;
    bf16_t* ACT; const float* RINV;
    __device__ __forceinline__ void operator()(AccRef acc, const Unit& u, int wr, int wc, int fr, int fq) const {
#pragma unroll
        for (int ai = 0; ai < 2; ++ai)
#pragma unroll
            for (int m = 0; m < 4; ++m) {
                const int row = u.pm * 256 + ai * 128 + wr * 64 + m * 16 + fr; const float rs = RINV[row];
                float a[8];
#pragma unroll
                for (int n = 0; n < 2; ++n)
#pragma unroll
                    for (int e = 0; e < 4; ++e) { const float gv = acc[ai][0][m][n][e] * rs, uv = acc[ai][1][m][n][e] * rs; a[n * 4 + e] = fast_silu(gv) * uv; }
                u32x4 w; w.x = cvt_pk_bf16(a[0], a[1]); w.y = cvt_pk_bf16(a[2], a[3]); w.z = cvt_pk_bf16(a[4], a[5]); w.w = cvt_pk_bf16(a[6], a[7]);
                *(u32x4*)(ACT + (size_t)row * FF + u.pn * 128 + wc * 32 + fq * 8) = w;
            }
    }
};
struct EpiYssq {
    static constexpr bool PERM = true, AFTER_DRAIN = false;
    bf16_t* Y; float* SSQ;
    __device__ __forceinline__ void operator()(AccRef acc, const Unit& u, int wr, int wc, int fr, int fq) const {
#pragma unroll
        for (int ai = 0; ai < 2; ++ai)
#pragma unroll
            for (int m = 0; m < 4; ++m) {
                const int row = u.pm * 256 + ai * 128 + wr * 64 + m * 16 + fr; float s = 0.f;
                bf16_t* rowp = Y + (size_t)row * DM + u.pn * 256 + wc * 32 + fq * 8;
#pragma unroll
                for (int bj = 0; bj < 2; ++bj) { const f32x4 v0 = acc[ai][bj][m][0], v1 = acc[ai][bj][m][1];
                    u32x4 w; w.x = cvt_pk_bf16(v0[0], v0[1]); w.y = cvt_pk_bf16(v0[2], v0[3]); w.z = cvt_pk_bf16(v1[0], v1[1]); w.w = cvt_pk_bf16(v1[2], v1[3]);
                    *(u32x4*)(rowp + bj * 128) = w;
                    s += (v0[0] * v0[0] + v0[1] * v0[1]) + (v0[2] * v0[2] + v0[3] * v0[3]) + (v1[0] * v1[0] + v1[1] * v1[1]) + (v1[2] * v1[2] + v1[3] * v1[3]); }
                s += __shfl_xor(s, 16); s += __shfl_xor(s, 32);
                if (fq == 0) SSQ[(size_t)row * 32 + u.pn * 4 + wc] = s;
            }
    }
};
struct EpiPre {
    static constexpr bool PERM = true;
    bf16_t* WCAT;
    __device__ __forceinline__ void operator()(AccRef acc, const Unit& u, int wr, int wc, int fr, int fq) const {
#pragma unroll
        for (int ai = 0; ai < 2; ++ai)
#pragma unroll
            for (int m = 0; m < 4; ++m) {
                const int row = u.pm * 256 + ai * 128 + wr * 64 + m * 16 + fr;
#pragma unroll
                for (int bj = 0; bj < 2; ++bj) { const f32x4 v0 = acc[ai][bj][m][0], v1 = acc[ai][bj][m][1];
                    u32x4 w; w.x = cvt_pk_bf16(v0[0], v0[1]); w.y = cvt_pk_bf16(v0[2], v0[3]); w.z = cvt_pk_bf16(v1[0], v1[1]); w.w = cvt_pk_bf16(v1[2], v1[3]);
                    *(u32x4*)(WCAT + (size_t)row * 4096 + u.pn * 256 + bj * 128 + wc * 32 + fq * 8) = w; }
            }
    }
};
struct EpiInner {
    static constexpr bool PERM = true;
    bf16_t* RA;
    __device__ __forceinline__ void operator()(AccRef acc, const Unit& u, int wr, int wc, int fr, int fq) const {
        const int h = u.aux; const float lg = ret_lg(h);
#pragma unroll
        for (int ai = 0; ai < 2; ++ai)
#pragma unroll
            for (int m = 0; m < 4; ++m) {
                int i = ai * 128 + wr * 64 + m * 16 + fr; asm volatile("" : "+v"(i)); const int row = u.pm * 256 + i;
                float lgm = lg; asm volatile("" : "+v"(lgm));
#pragma unroll
                for (int bj = 0; bj < 2; ++bj) { const int cb = bj * 128 + wc * 32 + fq * 8; float a[8];
#pragma unroll
                    for (int n = 0; n < 2; ++n)
#pragma unroll
                        for (int e = 0; e < 4; ++e) { const int d = i - (cb + n * 4 + e); const float dec = __builtin_amdgcn_exp2f((float)d * lgm); a[n * 4 + e] = d >= 0 ? acc[ai][bj][m][n][e] * dec : 0.f; }
                    u32x4 w; w.x = cvt_pk_bf16(a[0], a[1]); w.y = cvt_pk_bf16(a[2], a[3]); w.z = cvt_pk_bf16(a[4], a[5]); w.w = cvt_pk_bf16(a[6], a[7]);
                    *(u32x4*)(RA + (size_t)row * 2048 + h * 512 + cb) = w; __builtin_amdgcn_sched_barrier(0); }
            }
    }
};
struct EpiChain {
    static constexpr bool PERM = true;
    bf16_t* RB;
    __device__ __forceinline__ void operator()(f32x4 (&acc)[2][2][4][2], const Unit& u, int wr, int wc, int fr, int fq) const {
        const float cd = exp2f(256.0f * ret_lg(u.aux));
#pragma unroll
        for (int ai = 0; ai < 2; ++ai)
#pragma unroll
            for (int m = 0; m < 4; ++m) {
                const size_t row = (size_t)(u.pm + 2) * 256 + ai * 128 + wr * 64 + m * 16 + fr;
#pragma unroll
                for (int bj = 0; bj < 2; ++bj) { const f32x4 v0 = acc[ai][bj][m][0], v1 = acc[ai][bj][m][1];
                    u32x4 w; w.x = cvt_pk_bf16(v0[0], v0[1]); w.y = cvt_pk_bf16(v0[2], v0[3]); w.z = cvt_pk_bf16(v1[0], v1[1]); w.w = cvt_pk_bf16(v1[2], v1[3]);
                    *(u32x4*)(RB + row * 512 + 256 + bj * 128 + wc * 32 + fq * 8) = w;
                    acc[ai][bj][m][0] = v0 * cd; acc[ai][bj][m][1] = v1 * cd; }
            }
    }
};
struct EpiO {
    static constexpr bool PERM = true;
    bf16_t* ACAT; const bf16_t* SG; float* SSQO;
    __device__ __forceinline__ void operator()(AccRef acc, const Unit& u, int wr, int wc, int fr, int fq) const {
        const int h = u.aux, dvh = u.pn;
#pragma unroll
        for (int ai = 0; ai < 2; ++ai)
#pragma unroll
            for (int m = 0; m < 4; ++m) {
                const int row = u.pm * 256 + ai * 128 + wr * 64 + m * 16 + fr; float s = 0.f;
#pragma unroll
                for (int bj = 0; bj < 2; ++bj) { const int cg = h * 512 + dvh * 256 + bj * 128 + wc * 32 + fq * 8;
                    const u32x4 sg = *(const u32x4*)(SG + (size_t)row * 2048 + cg);
                    const f32x4 v0 = acc[ai][bj][m][0], v1 = acc[ai][bj][m][1];
                    s += (v0[0] * v0[0] + v0[1] * v0[1]) + (v0[2] * v0[2] + v0[3] * v0[3]) + (v1[0] * v1[0] + v1[1] * v1[1]) + (v1[2] * v1[2] + v1[3] * v1[3]);
                    u32x4 w; w.x = cvt_pk_bf16(v0[0] * bf_lo(sg.x), v0[1] * bf_hi(sg.x)); w.y = cvt_pk_bf16(v0[2] * bf_lo(sg.y), v0[3] * bf_hi(sg.y));
                    w.z = cvt_pk_bf16(v1[0] * bf_lo(sg.z), v1[1] * bf_hi(sg.z)); w.w = cvt_pk_bf16(v1[2] * bf_lo(sg.w), v1[3] * bf_hi(sg.w));
                    *(u32x4*)(ACAT + (size_t)row * 4096 + 2048 + cg) = w; }
                s += __shfl_xor(s, 16); s += __shfl_xor(s, 32);
                if (fq == 0) SSQO[((size_t)row * 4 + h) * 8 + dvh * 4 + wc] = s;
            }
    }
};
struct EpiCat {
    static constexpr bool PERM = true;
    bf16_t* MB; const bf16_t* G; const float* SSQO;
    __device__ __forceinline__ float rinv_o(int row, int h) const {
        const f32x4 p0 = *(const f32x4*)(SSQO + ((size_t)row * 4 + h) * 8), p1 = *(const f32x4*)(SSQO + ((size_t)row * 4 + h) * 8 + 4);
        const float ss = ((p0[0] + p0[1]) + (p0[2] + p0[3])) + ((p1[0] + p1[1]) + (p1[2] + p1[3])); return rsqrtf(ss * (1.0f / 512.0f) + EPS); }
    static __device__ __forceinline__ void unpack8(const u32x4 w, float (&f)[8]) { f[0] = bf_lo(w.x); f[1] = bf_hi(w.x); f[2] = bf_lo(w.y); f[3] = bf_hi(w.y); f[4] = bf_lo(w.z); f[5] = bf_hi(w.z); f[6] = bf_lo(w.w); f[7] = bf_hi(w.w); }
    __device__ __forceinline__ void operator()(f32x4 (&acc)[2][2][4][2], const Unit& u, int wr, int wc, int fr, int fq) const {
        const int u6 = u.aux;
#pragma unroll
        for (int ai = 0; ai < 2; ++ai)
#pragma unroll
            for (int m = 0; m < 4; ++m) {
                const int row = u.pm * 256 + ai * 128 + wr * 64 + m * 16 + fr;
                float rs_cur = 1.f, rs_nxt = 1.f;
                if (u6 >= 2) rs_cur = rinv_o(row, u6 - 2);
                if (u6 >= 1 && u6 <= 4) rs_nxt = rinv_o(row, u6 - 1);
                const bf16_t* grow = G + (size_t)row * 6144 + u.pn * 256 + wc * 32 + fq * 8;
#pragma unroll
                for (int bj = 0; bj < 2; ++bj) { const int cl = bj * 128;
                    float sc[8];
                    if (u6 == 0) { float gp[8], ga[8]; unpack8(*(const u32x4*)(grow + cl), gp); unpack8(*(const u32x4*)(grow + 2048 + cl), ga);
#pragma unroll
                        for (int e = 0; e < 8; ++e) sc[e] = gp[e] * __builtin_amdgcn_rcpf(ga[e]); }
                    else if (u6 == 1) { float ga[8], gr[8]; unpack8(*(const u32x4*)(grow + 2048 + cl), ga); unpack8(*(const u32x4*)(grow + 4096 + cl), gr);
#pragma unroll
                        for (int e = 0; e < 8; ++e) sc[e] = ga[e] * __builtin_amdgcn_rcpf(gr[e] * rs_nxt); }
                    else if (u6 < 5) { const float s1 = rs_cur * __builtin_amdgcn_rcpf(rs_nxt);
#pragma unroll
                        for (int e = 0; e < 8; ++e) sc[e] = s1; }
                    else { float gr[8]; unpack8(*(const u32x4*)(grow + 4096 + cl), gr);
#pragma unroll
                        for (int e = 0; e < 8; ++e) sc[e] = gr[e] * rs_cur; }
                    f32x4 v0 = acc[ai][bj][m][0], v1 = acc[ai][bj][m][1];
                    v0[0] *= sc[0]; v0[1] *= sc[1]; v0[2] *= sc[2]; v0[3] *= sc[3]; v1[0] *= sc[4]; v1[1] *= sc[5]; v1[2] *= sc[6]; v1[3] *= sc[7];
                    if (u6 < 5) { acc[ai][bj][m][0] = v0; acc[ai][bj][m][1] = v1; }
                    else { u32x4 w; w.x = cvt_pk_bf16(v0[0], v0[1]); w.y = cvt_pk_bf16(v0[2], v0[3]); w.z = cvt_pk_bf16(v1[0], v1[1]); w.w = cvt_pk_bf16(v1[2], v1[3]);
                        *(u32x4*)(MB + (size_t)row * DM + u.pn * 256 + wc * 32 + fq * 8 + cl) = w; }
                }
            }
    }
};
struct EpiInproj {
    static constexpr bool PERM = true;
    const float* RINV; bf16_t *XP, *Q, *KB, *VT, *RQ, *RK, *RA, *RKT, *RB, *SG, *G;
    __device__ __forceinline__ void operator()(AccRef acc, const Unit& u, int wr, int wc, int fr, int fq) const {
        const int pn = u.pn, pm = u.pm, b = pm >> 3, cc = pm & 7;
        int kind, hh = 0; bf16_t* dst = nullptr; int pitch = 0, cofs = 0;
        if (pn < 4) { kind = 0; dst = XP; pitch = 1024; cofs = pn * 256; }
        else if (pn < 8) { kind = 0; dst = Q; pitch = 1024; cofs = (pn - 4) * 256; }
        else if (pn == 8) { kind = 0; dst = KB; pitch = 256; cofs = 0; }
        else if (pn == 9) { kind = 1; }
        else if (pn < 14) { kind = 2; hh = pn - 10; }
        else if (pn < 18) { kind = 3; hh = pn - 14; }
        else if (pn < 26) { kind = 4; hh = (pn - 18) >> 1; }
        else if (pn < 34) { kind = 5; dst = SG; pitch = 2048; cofs = (pn - 26) * 256; }
        else { kind = 6; dst = G; pitch = 6144; cofs = (pn - 34) * 256; }
        const float lg = ret_lg(hh);
#pragma unroll
        for (int ai = 0; ai < 2; ++ai)
#pragma unroll
            for (int m = 0; m < 4; ++m) {
                int rl = ai * 128 + wr * 64 + m * 16 + fr; asm volatile("" : "+v"(rl)); const int row = pm * 256 + rl; const float rs = RINV[row];
                float lgm = lg; asm volatile("" : "+v"(lgm));
#pragma unroll
                for (int bj = 0; bj < 2; ++bj) { const int cb = bj * 128 + wc * 32 + fq * 8; float a[8];
#pragma unroll
                    for (int n = 0; n < 2; ++n)
#pragma unroll
                        for (int e = 0; e < 4; ++e) a[n * 4 + e] = acc[ai][bj][m][n][e] * rs;
                    if (kind == 0 || kind == 5 || kind == 6) {
                        if (kind == 5) {
#pragma unroll
                            for (int e = 0; e < 8; ++e) a[e] = fast_silu(a[e]); }
                        if (kind == 6) {
#pragma unroll
                            for (int e = 0; e < 8; ++e) a[e] = fast_sigmoid(a[e]); }
                        u32x4 w; w.x = cvt_pk_bf16(a[0], a[1]); w.y = cvt_pk_bf16(a[2], a[3]); w.z = cvt_pk_bf16(a[4], a[5]); w.w = cvt_pk_bf16(a[6], a[7]);
                        *(u32x4*)(dst + (size_t)row * pitch + cofs + cb) = w;
                    } else if (kind == 1) {
#pragma unroll
                        for (int e = 0; e < 8; ++e) { const int col = cb + e; VT[((size_t)(b * 4 + (col >> 6)) * 64 + (col & 63)) * SEQ + cc * 256 + (rl & ~15) + ((rl & 3) | (((rl >> 3) & 1) << 2) | (((rl >> 2) & 1) << 3))] = (bf16_t)(cvt_pk_bf16(a[e], 0.f) & 0xffffu); }
                    } else if (kind == 2) {
                        const float qd = __builtin_amdgcn_exp2f((float)(rl + 1) * lgm);
                        u32x4 w; w.x = cvt_pk_bf16(a[0], a[1]); w.y = cvt_pk_bf16(a[2], a[3]); w.z = cvt_pk_bf16(a[4], a[5]); w.w = cvt_pk_bf16(a[6], a[7]);
                        *(u32x4*)(RQ + (size_t)row * 1024 + hh * 256 + cb) = w;
                        w.x = cvt_pk_bf16(a[0] * qd, a[1] * qd); w.y = cvt_pk_bf16(a[2] * qd, a[3] * qd); w.z = cvt_pk_bf16(a[4] * qd, a[5] * qd); w.w = cvt_pk_bf16(a[6] * qd, a[7] * qd);
                        *(u32x4*)(RA + (size_t)row * 2048 + hh * 512 + 256 + cb) = w;
                    } else if (kind == 3) {
                        const float kd = __builtin_amdgcn_exp2f((float)(255 - rl) * lgm);
#pragma unroll
                        for (int e = 0; e < 8; ++e) a[e] *= 0.0625f;
                        u32x4 w; w.x = cvt_pk_bf16(a[0], a[1]); w.y = cvt_pk_bf16(a[2], a[3]); w.z = cvt_pk_bf16(a[4], a[5]); w.w = cvt_pk_bf16(a[6], a[7]);
                        *(u32x4*)(RK + (size_t)row * 1024 + hh * 256 + cb) = w;
#pragma unroll
                        for (int e = 0; e < 8; ++e) RKT[((size_t)pm * 256 + cb + e) * 1024 + hh * 256 + rl] = (bf16_t)(cvt_pk_bf16(a[e] * kd, 0.f) & 0xffffu);
                    } else {
                        const int dv0 = ((pn - 18) & 1) * 256 + cb;
#pragma unroll
                        for (int e = 0; e < 8; ++e) RB[((size_t)((b * 4 + hh) * 8 + cc) * 512 + dv0 + e) * 512 + rl] = (bf16_t)(cvt_pk_bf16(a[e], 0.f) & 0xffffu);
                    }
                }
            }
    }
};
}


#define XB_TMO      128
#define XB_XCNT(j)  (256  + 64 * (j))
#define XB_XSUB(j)  (1280 + 64 * (j))
#define XB_XGEN(j)  (2304 + 64 * (j))
#define XB_TOP      3328
#define XB_TOPGEN   3392
#define XCD_BAR_WORDS 3456
#define XB_SPIN_CAP (1u << 18)
__device__ __forceinline__ unsigned xb_ld(unsigned* p)              { return __hip_atomic_load(p, __ATOMIC_RELAXED, __HIP_MEMORY_SCOPE_AGENT); }
__device__ __forceinline__ unsigned xb_add(unsigned* p, unsigned v) { return __hip_atomic_fetch_add(p, v, __ATOMIC_RELAXED, __HIP_MEMORY_SCOPE_AGENT); }
__device__ __forceinline__ unsigned xb_xcc_id() { return (unsigned)__builtin_amdgcn_s_getreg((3 << 11) | 20) & 0xFu; }
#define XB_SPIN(cond, bar) do { unsigned _sp = 0; while (cond) { __builtin_amdgcn_s_sleep(1); \
    if ((++_sp & 255u) == 0u) { if (xb_ld(&(bar)[XB_TMO])) break; if (_sp > XB_SPIN_CAP) { atomicAdd(&(bar)[XB_TMO], 1u); break; } } } } while (0)
__device__ __forceinline__ void xcd_barrier_complete(unsigned* bar, unsigned x, unsigned& nloc, unsigned& nx) {
    const unsigned G = gridDim.x * gridDim.y * gridDim.z;
    unsigned sum, cnt, mine, sp = 0u;
    for (;;) {
        sum = 0u; cnt = 0u; mine = 0u;
#pragma unroll
        for (unsigned j = 0; j < 16; ++j) { const unsigned c = xb_ld(&bar[XB_XCNT(j)]); sum += c; cnt += (c > 0u) ? 1u : 0u; mine = (j == x) ? c : mine; }
        if (sum == G) break;
        __builtin_amdgcn_s_sleep(1);
        if ((++sp & 255u) == 0u) { if (xb_ld(&bar[XB_TMO])) break; if (sp > XB_SPIN_CAP) { atomicAdd(&bar[XB_TMO], 1u); break; } }
    }
    nloc = mine > 0u ? mine : 1u; nx = cnt > 0u ? cnt : 1u;
}
__device__ __forceinline__ void xcd_barrier(unsigned* bar, volatile LAS unsigned* st) {
    asm volatile("s_waitcnt vmcnt(0)" ::: "memory");
    __syncthreads();
    if (threadIdx.x == 0) {
        const unsigned x = xb_xcc_id();
        __builtin_amdgcn_s_waitcnt(0);
        unsigned nloc = st[0], nx = st[1];
        if (nloc == 0u) { xcd_barrier_complete(bar, x, nloc, nx); st[0] = nloc; st[1] = nx; }
        const unsigned old = xb_add(&bar[XB_XSUB(x)], 1u);
        const unsigned gen = old / nloc;
        if (old + 1u == (gen + 1u) * nloc) {
            __builtin_amdgcn_fence(__ATOMIC_RELEASE, "agent");
            asm volatile("s_waitcnt vmcnt(0)" ::: "memory");
            const unsigned og = xb_add(&bar[XB_TOP], 1u);
            const unsigned tg = og / nx;
            if (og + 1u == (tg + 1u) * nx) xb_add(&bar[XB_TOPGEN], 1u);
            else XB_SPIN(xb_ld(&bar[XB_TOPGEN]) == tg, bar);
            __builtin_amdgcn_fence(__ATOMIC_ACQUIRE, "agent");
            xb_add(&bar[XB_XGEN(x)], 1u);
            asm volatile("s_waitcnt vmcnt(0)" ::: "memory");
        } else {
            XB_SPIN(xb_ld(&bar[XB_XGEN(x)]) == gen, bar);
            __builtin_amdgcn_fence(__ATOMIC_ACQUIRE, "agent");
            asm volatile("s_waitcnt vmcnt(0)" ::: "memory");
        }
    }
    __syncthreads();
}

struct Args { const float* in[21]; float* out; unsigned char* ws; int ph_lo, ph_hi, coop, pad; };
typedef const __attribute__((address_space(4))) Args* ArgsP;

struct ConvDesc { const float* W; const float* kscale; bf16_t* dst; int K, N, ldd, coloff, rowoff, swiglu, item; };
__device__ __forceinline__ void conv_load(const ConvDesc& d, int lane, f32x4 (&v)[16], float (&sc)[16]) {
    const int nblk = d.N >> 6, kb = d.item / nblk, nb = d.item - kb * nblk, k0 = kb * 64, n0 = nb * 64, kr = lane >> 4, n = 4 * (lane & 15);
#pragma unroll
    for (int i = 0; i < 16; ++i) { v[i] = __builtin_nontemporal_load((const f32x4*)(d.W + (size_t)(k0 + 4 * i + kr) * d.N + n0 + n)); sc[i] = d.kscale ? d.kscale[k0 + 4 * i + kr] : 1.0f; }
}
__device__ __forceinline__ void conv_store(const ConvDesc& d, LAS float* scr, int lane, const f32x4 (&v)[16], const float (&sc)[16]) {
    const int nblk = d.N >> 6, kb = d.item / nblk, nb = d.item - kb * nblk, k0 = kb * 64, n0 = nb * 64, kr = lane >> 4, n = 4 * (lane & 15);
#pragma unroll
    for (int i = 0; i < 16; ++i) { LAS float* s = scr + (4 * i + kr) * 65 + n; s[0] = v[i][0] * sc[i]; s[1] = v[i][1] * sc[i]; s[2] = v[i][2] * sc[i]; s[3] = v[i][3] * sc[i]; }
    asm volatile("s_waitcnt lgkmcnt(0)" ::: "memory");
    const int c = lane & 7;
#pragma unroll
    for (int j = 0; j < 8; ++j) { const int nn = (lane >> 3) + 8 * j; const LAS float* s = scr + (8 * c) * 65 + nn;
        u32x4 o; o.x = cvt_pk_bf16(s[0 * 65], s[1 * 65]); o.y = cvt_pk_bf16(s[2 * 65], s[3 * 65]); o.z = cvt_pk_bf16(s[4 * 65], s[5 * 65]); o.w = cvt_pk_bf16(s[6 * 65], s[7 * 65]);
        int sn = n0 + nn, drow;
        if (d.swiglu) { const int bj = sn >= FF ? 1 : 0, jj = sn - bj * FF; drow = ((jj >> 7) << 8) + bj * 128 + (jj & 127); } else drow = d.rowoff + sn;
        *(u32x4*)(d.dst + (size_t)drow * d.ldd + d.coloff + k0 + 8 * c) = o; }
    asm volatile("s_waitcnt lgkmcnt(0)" ::: "memory");
}
__device__ __forceinline__ ConvDesc conv_decode(ArgsP ap, int l, int it) {
    unsigned char* ws = ap->ws;
    constexpr int I_UP = 32 * 176, I_DN = 88 * 32, I_IN = 32 * 136, I_GT = 32 * 96, I_AO = 16 * 32, I_RO = 32 * 32, I_WO = 32 * 32;
    int r = it;
    if (r < I_UP) return ConvDesc{ap->in[2] + (size_t)l * DM * 2 * FF, ap->in[1] + l * DM, (bf16_t*)(ws + WS_WUP1), DM, 2 * FF, DM, 0, 0, 1, r}; r -= I_UP;
    if (r < I_UP) return ConvDesc{ap->in[18] + (size_t)l * DM * 2 * FF, ap->in[17] + l * DM, (bf16_t*)(ws + WS_WUP2), DM, 2 * FF, DM, 0, 0, 1, r}; r -= I_UP;
    if (r < I_DN) return ConvDesc{ap->in[3] + (size_t)l * FF * DM, nullptr, (bf16_t*)(ws + WS_WDN1), FF, DM, FF, 0, 0, 0, r}; r -= I_DN;
    if (r < I_DN) return ConvDesc{ap->in[19] + (size_t)l * FF * DM, nullptr, (bf16_t*)(ws + WS_WDN2), FF, DM, FF, 0, 0, 0, r}; r -= I_DN;
    if (r < I_IN) return ConvDesc{ap->in[6] + (size_t)l * DM * 8704, ap->in[5] + l * DM, (bf16_t*)(ws + WS_WIN), DM, 8704, DM, 0, 0, 0, r}; r -= I_IN;
    if (r < I_GT) return ConvDesc{ap->in[14] + (size_t)l * DM * 6144, ap->in[5] + l * DM, (bf16_t*)(ws + WS_WIN), DM, 6144, DM, 0, 8704, 0, r}; r -= I_GT;
    if (r < I_AO) return ConvDesc{ap->in[12] + (size_t)l * 1024 * DM, nullptr, (bf16_t*)(ws + WS_WCAT), 1024, DM, 4096, 1024, 0, 0, r}; r -= I_AO;
    if (r < I_RO) return ConvDesc{ap->in[13] + (size_t)l * 2048 * DM, ap->in[10] + l * 2048, (bf16_t*)(ws + WS_WCAT), 2048, DM, 4096, 2048, 0, 0, r}; r -= I_RO;
    if (r < I_WO) return ConvDesc{ap->in[15] + (size_t)l * DM * DM, nullptr, (bf16_t*)(ws + WS_WOUT), DM, DM, DM, 0, 0, 0, r}; r -= I_WO;
    return ConvDesc{ap->in[11] + (size_t)l * 1024 * DM, ap->in[8] + l * 1024, (bf16_t*)(ws + WS_WPOT), 1024, DM, 1024, 0, 0, 0, r};
}
__device__ __forceinline__ void prep_layer(ArgsP ap, int l, LAS unsigned char* lds, int gw, int NGW, int wave, int lane) {
    LAS float* scr = (LAS float*)(lds + wave * 16640);
    constexpr int NIT = 2 * (32 * 176) + 2 * (88 * 32) + 32 * 136 + 32 * 96 + 16 * 32 + 32 * 32 + 32 * 32 + 16 * 32;
    if (gw < NIT) {
        int it = gw;
        ConvDesc dA = conv_decode(ap, l, it), dB = dA;
        f32x4 vA[16], vB[16]; float sA[16], sB[16];
        conv_load(dA, lane, vA, sA);
        for (;;) {
            it += NGW; const bool more1 = it < NIT;
            if (more1) { dB = conv_decode(ap, l, it); conv_load(dB, lane, vB, sB); }
            conv_store(dA, scr, lane, vA, sA);
            if (!more1) break;
            it += NGW; const bool more2 = it < NIT;
            if (more2) { dA = conv_decode(ap, l, it); conv_load(dA, lane, vA, sA); }
            conv_store(dB, scr, lane, vB, sB);
            if (!more2) break;
        }
    }
    const float* pw = ap->in[7] + (size_t)l * 262144; bf16_t* pg = (bf16_t*)(ap->ws + WS_WPG);
    for (int i = gw * 64 + lane; i < 65536; i += NGW * 64) { const f32x4 v = *(const f32x4*)(pw + (size_t)i * 4); u32x2 w; w.x = cvt_pk_bf16(v[0], v[1]); w.y = cvt_pk_bf16(v[2], v[3]); *(u32x2*)(pg + (size_t)i * 4) = w; }
}

__device__ __forceinline__ float wave_sum(float v) {
#pragma unroll
    for (int o = 1; o < 64; o <<= 1) v += __shfl_xor(v, o);
    return v;
}
__device__ __forceinline__ void rowpass(int src, int fin, const float* x, const bf16_t* Y, const float* SSQ, const float* post, float coef, float* OUT, bf16_t* HBF, float* RINV, int gw, int NGW, int rend, int lane) {
    for (int row0 = gw; row0 < rend; row0 += 2 * NGW) {
        f32x4 v[2][8]; float s2[2];
#pragma unroll
        for (int q = 0; q < 2; ++q) {
            const int row = row0 + q * NGW;
            const bool ok = row < rend; const int rr = ok ? row : row0;
            float ry = 0.f;
            if (src) { const float p = SSQ[(size_t)rr * 32 + (lane & 31)]; float s = p;
#pragma unroll
                for (int o = 1; o < 32; o <<= 1) s += __shfl_xor(s, o);
                ry = rsqrtf(s * (1.0f / DM) + EPS) * coef; }
            const f32x4* xp = (const f32x4*)(x + (size_t)rr * DM) + lane; const u32x2* yp = (const u32x2*)(Y + (size_t)rr * DM) + lane; const f32x4* pp = (const f32x4*)post + lane;
            const u32x2* bp = (const u32x2*)(HBF + (size_t)rr * DM) + lane;
            float acc2 = 0.f;
#pragma unroll
            for (int j = 0; j < 8; ++j) {
                f32x4 t;
                if (src == 2) { const u32x2 hw = bp[64 * j]; t = (f32x4){bf_lo(hw.x), bf_hi(hw.x), bf_lo(hw.y), bf_hi(hw.y)}; } else t = xp[64 * j];
                if (src) { const u32x2 yw = yp[64 * j]; const f32x4 y = (f32x4){bf_lo(yw.x), bf_hi(yw.x), bf_lo(yw.y), bf_hi(yw.y)}, g = pp[64 * j]; t += y * g * ry; }
                acc2 += (t[0] * t[0] + t[1] * t[1]) + (t[2] * t[2] + t[3] * t[3]); v[q][j] = t; }
            s2[q] = acc2;
        }
#pragma unroll
        for (int q = 0; q < 2; ++q) {
            const int row = row0 + q * NGW; if (row >= rend) continue;
            const float tot = wave_sum(s2[q]);
            if (fin) { f32x4* op = (f32x4*)(OUT + (size_t)row * DM) + lane;
#pragma unroll
                for (int j = 0; j < 8; ++j) op[64 * j] = v[q][j]; }
            else { u32x2* bp = (u32x2*)(HBF + (size_t)row * DM) + lane;
#pragma unroll
                for (int j = 0; j < 8; ++j) { u32x2 w; w.x = cvt_pk_bf16(v[q][j][0], v[q][j][1]); w.y = cvt_pk_bf16(v[q][j][2], v[q][j][3]); bp[64 * j] = w; }
                if (lane == 0) RINV[row] = rsqrtf(tot * (1.0f / DM) + EPS); }
        }
    }
}

__device__ __forceinline__ void pool_phase(const bf16_t* XP, bf16_t* ACAT, int gtid, int NT) {
    for (int it = gtid; it < MTOK * 128; it += NT) {
        const int row = it >> 7, c0 = (it & 127) * 8, w = 2 << (c0 >> 8), t = row & (SEQ - 1), cnt = (t + 1) < w ? (t + 1) : w;
        float s[8], self[8];
        u32x4 vv[16];
#pragma unroll
        for (int k = 0; k < 16; ++k) { vv[k] = (u32x4){0u, 0u, 0u, 0u}; if (k < cnt) vv[k] = *(const u32x4*)(XP + (size_t)(row - k) * 1024 + c0); }
        { const u32x4 v = vv[0];
          self[0] = bf_lo(v.x); self[1] = bf_hi(v.x); self[2] = bf_lo(v.y); self[3] = bf_hi(v.y); self[4] = bf_lo(v.z); self[5] = bf_hi(v.z); self[6] = bf_lo(v.w); self[7] = bf_hi(v.w); }
#pragma unroll
        for (int e = 0; e < 8; ++e) s[e] = self[e];
#pragma unroll
        for (int k = 1; k < 16; ++k) { const u32x4 v = vv[k];
            s[0] += bf_lo(v.x); s[1] += bf_hi(v.x); s[2] += bf_lo(v.y); s[3] += bf_hi(v.y); s[4] += bf_lo(v.z); s[5] += bf_hi(v.z); s[6] += bf_lo(v.w); s[7] += bf_hi(v.w); }
        const float ic = 1.0f / (float)cnt;
        u32x4 o; o.x = cvt_pk_bf16(s[0] * ic - self[0], s[1] * ic - self[1]); o.y = cvt_pk_bf16(s[2] * ic - self[2], s[3] * ic - self[3]);
        o.z = cvt_pk_bf16(s[4] * ic - self[4], s[5] * ic - self[5]); o.w = cvt_pk_bf16(s[6] * ic - self[6], s[7] * ic - self[7]);
        *(u32x4*)(ACAT + (size_t)row * 4096 + c0) = o;
    }
}

__device__ __forceinline__ void attn_phase(const bf16_t* Q, const bf16_t* Kb, const bf16_t* VT, const float* sinks, bf16_t* ACAT, int gw, int NGW, int lane) {
    const int r = lane & 31, hl = lane >> 5;
    for (int it = gw; it < 4096; it += NGW) {
        const int qs = it & 3, g = (it >> 2) & 3, hkv = (it >> 4) & 3, n = (it >> 6) & 15, b = it >> 10;
        const int h = hkv * 4 + g, t0 = n * 128 + qs * 32;
        const size_t rowq = (size_t)b * SEQ + t0 + r;
        bf16x8 qf[4];
#pragma unroll
        for (int kk = 0; kk < 4; ++kk) qf[kk] = *(const bf16x8*)(Q + rowq * 1024 + h * 64 + kk * 16 + hl * 8);
        const float slope = exp2f(-0.5f * (float)(h + 1)), sink = sinks[h];
        float mx = sink, lsum = 0.f; f32x16 o[2];
#pragma unroll
        for (int e = 0; e < 16; ++e) { o[0][e] = 0.f; o[1][e] = 0.f; }
        const int kt_lo = t0 >= 128 ? 0 : 4 - (t0 >> 5);
#pragma nounroll
        for (int kt = kt_lo; kt < 5; ++kt) {
            const int ks = t0 - 128 + 32 * kt;
            f32x16 acc;
#pragma unroll
            for (int e = 0; e < 16; ++e) acc[e] = 0.f;
            const bf16_t* kp = Kb + ((size_t)b * SEQ + ks + r) * 256 + hkv * 64 + hl * 8;
            bf16x8 kf[4]; u32x4 vf[2][2];
#pragma unroll
            for (int kk = 0; kk < 4; ++kk) kf[kk] = *(const bf16x8*)(kp + kk * 16);
#pragma unroll
            for (int st = 0; st < 2; ++st)
#pragma unroll
                for (int dt = 0; dt < 2; ++dt) vf[st][dt] = *(const u32x4*)(VT + ((size_t)(b * 4 + hkv) * 64 + dt * 32 + r) * SEQ + ks + 16 * st + 8 * hl);
#pragma unroll
            for (int kk = 0; kk < 4; ++kk) acc = __builtin_amdgcn_mfma_f32_32x32x16_bf16(kf[kk], qf[kk], acc, 0, 0, 0);
            float tm = -__builtin_inff();
#pragma unroll
            for (int e = 0; e < 16; ++e) { const int keyrow = (e & 3) + 8 * (e >> 2) + 4 * hl; const int dist = 128 - 32 * kt + r - keyrow;
                const float v = (dist >= 0 && dist < 128) ? acc[e] * 0.125f - slope * (float)dist : -__builtin_inff();
                acc[e] = v; tm = fmaxf(tm, v); }
            tm = fmaxf(tm, __shfl_xor(tm, 32));
            const float mnew = fmaxf(mx, tm), alpha = __expf(mx - mnew);
            mx = mnew; lsum *= alpha;
#pragma unroll
            for (int e = 0; e < 16; ++e) { o[0][e] *= alpha; o[1][e] *= alpha; }
            float p[16];
#pragma unroll
            for (int e = 0; e < 16; ++e) { p[e] = __expf(acc[e] - mnew); lsum += p[e]; }
#pragma unroll
            for (int st = 0; st < 2; ++st) {
                u32x4 pw; pw.x = cvt_pk_bf16(p[8 * st + 0], p[8 * st + 1]); pw.y = cvt_pk_bf16(p[8 * st + 2], p[8 * st + 3]); pw.z = cvt_pk_bf16(p[8 * st + 4], p[8 * st + 5]); pw.w = cvt_pk_bf16(p[8 * st + 6], p[8 * st + 7]);
                const bf16x8 pb = __builtin_bit_cast(bf16x8, pw);
#pragma unroll
                for (int dt = 0; dt < 2; ++dt) o[dt] = __builtin_amdgcn_mfma_f32_32x32x16_bf16(__builtin_bit_cast(bf16x8, vf[st][dt]), pb, o[dt], 0, 0, 0);
            }
        }
        lsum += __shfl_xor(lsum, 32); lsum += __expf(sink - mx);
        const float inv = 1.0f / lsum;
#pragma unroll
        for (int dt = 0; dt < 2; ++dt)
#pragma unroll
            for (int i = 0; i < 4; ++i) { u32x2 w; w.x = cvt_pk_bf16(o[dt][4 * i] * inv, o[dt][4 * i + 1] * inv); w.y = cvt_pk_bf16(o[dt][4 * i + 2] * inv, o[dt][4 * i + 3] * inv);
                *(u32x2*)(ACAT + rowq * 4096 + 1024 + h * 64 + dt * 32 + 8 * i + 4 * hl) = w; }
    }
}

__device__ __forceinline__ void scan_phase(const bf16_t* DS, bf16_t* RB, int gtid, int NT) {
    for (int it = gtid; it < 16 * 512 * 32; it += NT) {
        const int dk8 = it & 31, dv = (it >> 5) & 511, bh = it >> 14, h = bh & 3;
        const float cd = exp2f(256.0f * ret_lg(h));
        u32x4 dw[7];
#pragma unroll
        for (int c = 0; c < 7; ++c) dw[c] = *(const u32x4*)(DS + ((size_t)(bh * 8 + c) * 512 + dv) * 256 + dk8 * 8);
        f32x4 s0 = (f32x4){0.f, 0.f, 0.f, 0.f}, s1 = s0;
#pragma unroll
        for (int c = 0; c < 7; ++c) {
            s0 = s0 * cd + (f32x4){bf_lo(dw[c].x), bf_hi(dw[c].x), bf_lo(dw[c].y), bf_hi(dw[c].y)}; s1 = s1 * cd + (f32x4){bf_lo(dw[c].z), bf_hi(dw[c].z), bf_lo(dw[c].w), bf_hi(dw[c].w)};
            u32x4 w; w.x = cvt_pk_bf16(s0[0], s0[1]); w.y = cvt_pk_bf16(s0[2], s0[3]); w.z = cvt_pk_bf16(s1[0], s1[1]); w.w = cvt_pk_bf16(s1[2], s1[3]);
            *(u32x4*)(RB + ((size_t)(bh * 8 + c + 1) * 512 + dv) * 512 + 256 + dk8 * 8) = w;
        }
    }
}

__global__ void __launch_bounds__(512, 2) fwd_megakernel(Args a_unused) {
    extern __shared__ __attribute__((aligned(16))) unsigned char lds_raw[];
    LAS unsigned char* lds = (LAS unsigned char*)lds_raw;
    ArgsP ap0 = (ArgsP)__builtin_amdgcn_kernarg_segment_ptr();
    const int ph_lo = ap0->ph_lo, ph_hi = ap0->ph_hi, coop = ap0->coop;
#if REP
    unsigned char* ws0 = ap0->ws;
#endif
    const int wave0 = __builtin_amdgcn_readfirstlane((int)threadIdx.x >> 6);
    volatile LAS unsigned* bar_st = (volatile LAS unsigned*)(lds + LDS_BYTES - 64);
    if (threadIdx.x == 0) { bar_st[0] = 0u; bar_st[1] = 0u; if (coop) (void)xb_add((unsigned*)(ap0->ws + WS_BAR) + XB_XCNT(xb_xcc_id()), 1u); }
    __syncthreads();
#if REP
    for (int step = 2 * ph_lo; step < 2 * ph_hi; ++step) {
    const int ph = step >> 1;
    if (step & 1) { const int pp = ph == 0 ? 0 : (ph - 1) % 13 + 1; bool again = false;
        if ((REP & 1) && (pp == 0 || (pp == 13 && ph < 14))) again = true;
        if ((REP & 4) && (pp == 1 || pp == 2 || pp == 11 || pp == 12)) again = true;
        if ((REP & 8) && pp == 4) again = true;
        if ((REP & 16) && pp == 5) again = true;
        if ((REP & 32) && pp == 6) again = true;
        if ((REP & 64) && pp == 7) again = true;
        if ((REP & 128) && pp == 8) again = true;
        if ((REP & 256) && pp == 9) again = true;
        if (REP & 2) { if (ph + 1 < ph_hi && coop) xcd_barrier((unsigned*)(ws0 + WS_BAR), bar_st); continue; }
        if (!again) continue; }
#else
    for (int ph = ph_lo; ph < ph_hi; ++ph) {
#endif
    if (ph != 0 && (ph - 1) % 13 + 1 == 6) continue;
    ArgsP ap = ap0; asm volatile("" : "+s"(ap));
    int tid; asm volatile("v_mbcnt_lo_u32_b32 %0, -1, 0\n\tv_mbcnt_hi_u32_b32 %0, -1, %0" : "=v"(tid)); tid += wave0 * 64;
    int G = gridDim.x, c = blockIdx.x; asm volatile("" : "+s"(G), "+s"(c));
    const int lane = tid & 63, wave = __builtin_amdgcn_readfirstlane(tid >> 6);
    const int gw = c * 8 + wave, NGW = G * 8, gtid = c * 512 + tid, NT = G * 512;
    int rp_gw = gw, rp_n = NGW, rp_end = MTOK;
    if (G == 256) { const int xq = c & 7, kq = c >> 3, bq = xq >> 1; rp_gw = bq * SEQ + ((xq & 1) * 32 + kq) * 8 + wave; rp_n = 512; rp_end = (bq + 1) * SEQ; }
    unsigned char* ws = ap->ws; asm volatile("" : "+s"(ws));
    bf16_t* HBF = (bf16_t*)(ws + WS_HBF); bf16_t* Y = (bf16_t*)(ws + WS_Y); float* SSQ = (float*)(ws + WS_SSQ); float* RINV = (float*)(ws + WS_RINV); float* SSQO = (float*)(ws + WS_SSQO);
    bf16_t* ACT = (bf16_t*)(ws + WS_ACT); bf16_t* Gt = (bf16_t*)(ws + WS_G); bf16_t* XP = (bf16_t*)(ws + WS_XP); bf16_t* Qb = (bf16_t*)(ws + WS_Q); bf16_t* KB = (bf16_t*)(ws + WS_KB);
    bf16_t* VT = (bf16_t*)(ws + WS_VT); bf16_t* RQ = (bf16_t*)(ws + WS_RQ); bf16_t* RK = (bf16_t*)(ws + WS_RK); bf16_t* RA = (bf16_t*)(ws + WS_RA); bf16_t* RKT = (bf16_t*)(ws + WS_RKT);
    bf16_t* RB = (bf16_t*)(ws + WS_RB); bf16_t* SG = (bf16_t*)(ws + WS_SG); bf16_t* DS = (bf16_t*)(ws + WS_DS); float* MF = (float*)(ws + WS_MF); bf16_t* ACAT = (bf16_t*)(ws + WS_ACAT); bf16_t* MB = (bf16_t*)(ws + WS_MB);
    float* H = ap->out;

        if (ph == 0) {
            prep_layer(ap, 0, lds, gw, NGW, wave, lane);
            rowpass(0, 0, ap->in[0], nullptr, nullptr, nullptr, 0.f, H, HBF, RINV, rp_gw, rp_n, rp_end, lane);
        } else {
            const int l = (ph - 1) / 13, p = (ph - 1) % 13 + 1;

            if (p == 1 || p == 11) {
                pg8::Gemm g{HBF, (const bf16_t*)(ws + (p == 1 ? WS_WUP1 : WS_WUP2)), DM, DM};
                pg8::SchedStd S{32, 44, G, c, DM, DM, 32};
                pg8::EpiSwiglu E{ACT, RINV};
                pg8::gemm_phase(lds, g, S, E, tid);
                if (p == 1) {
                    pg8::Gemm g2{(const bf16_t*)(ws + WS_WPOT), (const bf16_t*)(ws + WS_WPG), 1024, 256};
                    pg8::SchedPre S2{G, G - 1 - c};
                    pg8::EpiPre E2{(bf16_t*)(ws + WS_WCAT)};
                    pg8::gemm_phase(lds, g2, S2, E2, tid);
                }
            } else if (p == 2 || p == 12) {
                pg8::Gemm g{ACT, (const bf16_t*)(ws + (p == 2 ? WS_WDN1 : WS_WDN2)), FF, FF};
                pg8::SchedStd S{32, 8, G, c, FF, FF, 88};
                pg8::EpiYssq E{Y, SSQ};
                pg8::gemm_phase(lds, g, S, E, tid);
            } else if (p == 3 || p == 10 || p == 13) {
                const float* post = (p == 3 ? ap->in[4] : (p == 10 ? ap->in[16] : ap->in[20])) + l * DM;
#if REP
                if (!(step & 1))
#endif
                rowpass((l == 0 && p == 3) ? 1 : 2, (l == 1 && p == 13) ? 1 : 0, ap->in[0], Y, SSQ, post, p == 10 ? 1.0f : 0.5f, H, HBF, RINV, rp_gw, rp_n, rp_end, lane);
                if (p == 13 && l == 0) prep_layer(ap, 1, lds, gw, NGW, wave, lane);
            } else if (p == 4) {
                pg8::Gemm g{HBF, (const bf16_t*)(ws + WS_WIN), DM, DM};
                pg8::SchedStd S{32, 58, G, c, DM, DM, 32};
                pg8::EpiInproj E{RINV, XP, Qb, KB, VT, RQ, RK, RA, RKT, RB, SG, Gt};
                pg8::gemm_phase(lds, g, S, E, tid);
            } else if (p == 5) {
                if (c < 32) {
                    pg8::Gemm g{RB, RKT, 512, 1024}; pg8::SchedChain S{c}; pg8::EpiChain E{RB}; pg8::gemm_phase(lds, g, S, E, tid);
                } else {
                    const int G2 = G - 32, c2 = c - 32;
                    { pg8::Gemm g{RQ, RK, 1024, 1024}; pg8::SchedInner S{G2, c2}; pg8::EpiInner E{RA}; pg8::gemm_phase(lds, g, S, E, tid); }
                    attn_phase(Qb, KB, VT, ap->in[9] + l * 16, ACAT, G2 * 8 - 1 - (c2 * 8 + wave), G2 * 8, lane);
                    pool_phase(XP, ACAT, c2 * 512 + tid, G2 * 512);
                }
            } else if (p == 7) {
                pg8::Gemm g{RA, RB, 2048, 512}; pg8::SchedO S{G, c}; pg8::EpiO E{ACAT, SG, SSQO}; pg8::gemm_phase(lds, g, S, E, tid);
            } else if (p == 8) {
                pg8::Gemm g{ACAT, (const bf16_t*)(ws + WS_WCAT), 4096, 4096}; pg8::SchedCat S{G, c}; pg8::EpiCat E{MB, Gt, SSQO}; pg8::gemm_phase(lds, g, S, E, tid);
            } else if (p == 9) {
                pg8::Gemm g{MB, (const bf16_t*)(ws + WS_WOUT), DM, DM};
                pg8::SchedStd S{32, 8, G, c, DM, DM, 32};
                pg8::EpiYssq E{Y, SSQ};
                pg8::gemm_phase(lds, g, S, E, tid);
            }
        }
#if REP
        if (ph + 1 < ph_hi || !(step & 1)) {
#else
        if (ph + 1 < ph_hi) {
#endif
            if (coop) { if (coop == 2) cg::this_grid().sync(); else xcd_barrier((unsigned*)(ws + WS_BAR), bar_st); }
        }
    }
}

extern "C" void kernel_launch(void* const* d_in, const int* in_sizes, int n_in, void* d_out, int out_size, void* d_ws, size_t ws_size, hipStream_t stream) {
    static int grid = 0;
    if (grid == 0) {
        if (n_in != 21 || out_size != MTOK * DM || ws_size < WS_END) { fprintf(stderr, "kernel_launch: unexpected shapes (n_in %d out %d ws %zu)\n", n_in, out_size, ws_size); grid = -1; return; }
        int dev = 0, cus = 0, per_cu = 0;
        hipGetDevice(&dev);
        hipDeviceGetAttribute(&cus, hipDeviceAttributeMultiprocessorCount, dev);
        if (hipFuncSetAttribute((const void*)fwd_megakernel, hipFuncAttributeMaxDynamicSharedMemorySize, LDS_BYTES) != hipSuccess) { fprintf(stderr, "kernel_launch: hipFuncSetAttribute failed\n"); grid = -1; return; }
        hipOccupancyMaxActiveBlocksPerMultiprocessor(&per_cu, (const void*)fwd_megakernel, 512, LDS_BYTES);
        (void)hipGetLastError();
        if (per_cu < 1) per_cu = 1;
        grid = cus * per_cu;
        if (grid > 256) grid = 256;
        fprintf(stderr, "kernel_launch: cus %d per_cu %d grid %d\n", cus, per_cu, grid);
    }
    if (grid < 0) return;
    Args a{};
    for (int i = 0; i < 21; ++i) a.in[i] = (const float*)d_in[i];
    a.out = (float*)d_out; a.ws = (unsigned char*)d_ws; a.pad = 0;
#if MK_COOP
    if (hipMemsetAsync((char*)d_ws + WS_BAR, 0, XCD_BAR_WORDS * 4, stream) != hipSuccess) { fprintf(stderr, "kernel_launch: memset failed\n"); return; }
    a.ph_lo = 0; a.ph_hi = NPHASE; a.coop = 1;
    void* args[] = {&a};
    hipError_t e = hipLaunchCooperativeKernel((const void*)fwd_megakernel, dim3(grid), dim3(512), args, LDS_BYTES, stream);
    if (e != hipSuccess) fprintf(stderr, "cooperative launch failed: %s (grid %d)\n", hipGetErrorString(e), grid);
#else
    a.coop = 0;
    for (int ph = 0; ph < NPHASE; ++ph) { a.ph_lo = ph; a.ph_hi = ph + 1; hipLaunchKernelGGL(fwd_megakernel, dim3(grid), dim3(512), LDS_BYTES, stream, a); }
#endif
}
```

```cpp
#include <hip/hip_runtime.h>
#include <hip/hip_cooperative_groups.h>
#include <cstdio>
#include <cstdint>
namespace cg = cooperative_groups;

#ifndef MK_COOP
#define MK_COOP 1
#endif
#ifndef REP
#define REP 0
#endif

#define LAS __attribute__((address_space(3)))
typedef unsigned short bf16_t;
typedef short bf16x8 __attribute__((ext_vector_type(8)));
typedef float f32x4 __attribute__((ext_vector_type(4)));
typedef float f32x16 __attribute__((ext_vector_type(16)));
typedef unsigned u32x4 __attribute__((ext_vector_type(4)));
typedef unsigned u32x2 __attribute__((ext_vector_type(2)));

constexpr int MTOK = 8192, DM = 2048, FF = 5632, SEQ = 2048;
constexpr int NIN = 14848;
constexpr float EPS = 1e-6f;
constexpr int NPHASE = 27;

constexpr size_t MiB = (size_t)1 << 20;
constexpr size_t WS_WUP1 = 0, WS_WDN1 = 44 * MiB, WS_WUP2 = 66 * MiB, WS_WDN2 = 110 * MiB, WS_WIN = 132 * MiB, WS_WCAT = 190 * MiB,
                 WS_WOUT = 206 * MiB, WS_WPOT = 214 * MiB, WS_WPG = 218 * MiB, WS_HBF = 220 * MiB, WS_Y = 252 * MiB, WS_SSQ = 316 * MiB,
                 WS_RINV = 317 * MiB, WS_SSQO = 318 * MiB, WS_BAR = 319 * MiB, WS_ACT = 320 * MiB, WS_G = 320 * MiB, WS_XP = 416 * MiB, WS_Q = 432 * MiB,
                 WS_KB = 448 * MiB, WS_VT = 452 * MiB, WS_RQ = 456 * MiB, WS_RK = 472 * MiB, WS_RA = 488 * MiB, WS_RKT = 520 * MiB,
                 WS_RB = 536 * MiB, WS_SG = 600 * MiB, WS_DS = 632 * MiB, WS_MF = 632 * MiB, WS_ACAT = 696 * MiB, WS_MB = 760 * MiB,
                 WS_END = 792 * MiB;

constexpr int LDS_BYTES = 147456;

__device__ __forceinline__ unsigned cvt_pk_bf16(float lo, float hi) { unsigned r; asm volatile("v_cvt_pk_bf16_f32 %0, %1, %2" : "=v"(r) : "v"(lo), "v"(hi)); return r; }
__device__ __forceinline__ float bf_lo(unsigned w) { return __uint_as_float(w << 16); }
__device__ __forceinline__ float bf_hi(unsigned w) { return __uint_as_float(w & 0xffff0000u); }
__device__ __forceinline__ float fast_sigmoid(float x) { return __builtin_amdgcn_rcpf(1.0f + __builtin_amdgcn_exp2f(-1.4426950409f * x)); }
__device__ __forceinline__ float fast_silu(float x) { return x * fast_sigmoid(x); }
__device__ __forceinline__ float ret_lg(int h) { return log2f(1.0f - exp2f(-5.0f - (float)h)); }

namespace pg8 {
constexpr int BM = 256, BK = 64, HALF = 128, HTB = HALF * BK * 2, STAGE_BYTES = 8 * HTB, NXCD = 8, WGM = 8;
__device__ __forceinline__ int lds_byte(int r, int c) { const int st = (r >> 4) * 2 + (c >> 5), rr = r & 15, cc = c & 31, ob = rr * 64 + cc * 2; return st * 1024 + (ob ^ (((ob >> 9) & 1) << 5)); }
__device__ __forceinline__ void stage_rc(int b, int& R, int& C) { const int st = b / 1024, sb = b % 1024, swz = sb ^ (((sb >> 9) & 1) << 5); R = (st >> 1) * 16 + swz / 64; C = (st & 1) * 32 + (swz % 64) / 2; }
__device__ __forceinline__ int perm32(int rho) { const int n = rho >> 4, i = rho & 15; return 8 * (i >> 2) + 4 * n + (i & 3); }

struct Unit { size_t aoff, boff; int nt, pm, pn, aux, first; };
struct Gemm { const bf16_t* A; const bf16_t* Bt; int lda, ldb; };

__device__ __forceinline__ void tile_map(int L, int nM, int nN, int& pm, int& pn) {
    const int nwg = nM * nN; int wgid = L;
    { const int q = nwg / NXCD, r = nwg % NXCD, xcd = wgid % NXCD, off = wgid / NXCD; wgid = (xcd < r ? xcd * (q + 1) : r * (q + 1) + (xcd - r) * q) + off; }
    const int nig = WGM * nN, gid = wgid / nig, fm = gid * WGM, gsz = (nM - fm) < WGM ? (nM - fm) : WGM;
    pm = fm + ((wgid % nig) % gsz); pn = (wgid % nig) / gsz;
}

template <class Epi, class Sched>
__device__ __forceinline__ void gemm_phase(LAS unsigned char* lds, const Gemm g, const Sched& S, const Epi& E, const int tid) {
    const int wid = __builtin_amdgcn_readfirstlane(tid >> 6), lane = tid & 63, wr = wid >> 2, wc = wid & 3, fr = lane & 15, fq = lane >> 4;
    unsigned voffA, voffB;
    { int R, C; stage_rc(tid * 16, R, C); const int Rb = Epi::PERM ? ((R & ~31) + perm32(R & 31)) : R;
        voffA = (unsigned)(R * g.lda + C) * 2u; voffB = (unsigned)(Rb * g.ldb + C) * 2u; }
    const size_t d64A = (size_t)64 * g.lda * 2, d64B = (size_t)64 * g.ldb * 2;
    const size_t kstep = (size_t)(BK * 2);
    const size_t hstepA = (size_t)HALF * g.lda * 2, hstepB = (size_t)HALF * g.ldb * 2;
    const unsigned ldsw = (unsigned)wid * 1024u;
    const int aoff = lds_byte(wr * 64 + fr, fq * 8), boff = lds_byte(wc * 32 + fr, fq * 8);
#define d64offA d64A
#define d64offB d64B
#define PG8_SA(b, h) (((b) * 2 + (h)) * HTB)
#define PG8_SB(b, h) ((4 + (b) * 2 + (h)) * HTB)
#define PG8_STAGE(bufoff, gbase, voff) do { _Pragma("unroll") for (int _i = 0; _i < 2; ++_i) \
        __builtin_amdgcn_global_load_lds((const unsigned*)((const char*)(gbase) + (size_t)_i * d64##voff + v##voff), (LAS unsigned*)(lds + (bufoff) + ldsw + _i * 8192), 16, 0, 0); } while (0)
#define PG8_LDA(dst, b, h) do { _Pragma("unroll") for (int m = 0; m < 4; ++m) _Pragma("unroll") for (int k = 0; k < 2; ++k) dst[m][k] = *(const LAS bf16x8*)(lds + PG8_SA(b, h) + aoff + m * 2048 + k * 1024); } while (0)
#define PG8_LDB(dst, b, h) do { _Pragma("unroll") for (int n = 0; n < 2; ++n) _Pragma("unroll") for (int k = 0; k < 2; ++k) dst[n][k] = *(const LAS bf16x8*)(lds + PG8_SB(b, h) + boff + n * 2048 + k * 1024); } while (0)
#define PG8_MMA(ai, bj, At, Bt) do { __builtin_amdgcn_s_setprio(1); _Pragma("unroll") for (int m = 0; m < 4; ++m) _Pragma("unroll") for (int n = 0; n < 2; ++n) _Pragma("unroll") for (int k = 0; k < 2; ++k) \
        acc[ai][bj][m][n] = __builtin_amdgcn_mfma_f32_16x16x32_bf16(Bt[n][k], At[m][k], acc[ai][bj][m][n], 0, 0, 0); __builtin_amdgcn_s_setprio(0); } while (0)
#define PG8_WAIT_V(n) asm volatile("s_waitcnt vmcnt(" #n ")" ::: "memory")
#define PG8_WAIT_L(n) asm volatile("s_waitcnt lgkmcnt(" #n ")" ::: "memory")
#define PG8_BAR __builtin_amdgcn_s_barrier()
#define PG8_SCHED __builtin_amdgcn_sched_barrier(0)
    Unit cur, nxt; int ui = 0;
    if (!S.next(0, cur)) return;
    f32x4 acc[2][2][4][2];
#pragma unroll
    for (int a = 0; a < 2; ++a)
#pragma unroll
        for (int b = 0; b < 2; ++b)
#pragma unroll
            for (int m = 0; m < 4; ++m)
#pragma unroll
                for (int n = 0; n < 2; ++n) acc[a][b][m][n] = (f32x4){0.f, 0.f, 0.f, 0.f};
    bf16x8 At[4][2], B0[2][2], B1[2][2];
    const char* cA = (const char*)g.A + cur.aoff; const char* cB = (const char*)g.Bt + cur.boff;
    PG8_STAGE(PG8_SB(0, 0), cB, offB); PG8_STAGE(PG8_SB(0, 1), cB + hstepB, offB); PG8_STAGE(PG8_SA(0, 0), cA, offA); PG8_STAGE(PG8_SA(0, 1), cA + hstepA, offA);
    if (wr == 1) PG8_BAR;
    PG8_WAIT_V(2); PG8_BAR;
    PG8_STAGE(PG8_SB(1, 0), cB + kstep, offB); PG8_STAGE(PG8_SA(1, 0), cA + kstep, offA); PG8_STAGE(PG8_SB(1, 1), cB + hstepB + kstep, offB);
    PG8_WAIT_V(6); PG8_BAR;
    for (;;) {
        const bool has_next = S.next(ui + 1, nxt);
        const char* nA = has_next ? (const char*)g.A + nxt.aoff : cA; const char* nB = has_next ? (const char*)g.Bt + nxt.boff : cB;
        int nt = cur.nt; asm volatile("" : "+s"(nt));
#pragma nounroll
        for (int t = 0; t < nt; t += 2) {
            const bool last = (t == nt - 2);
            const char* a1 = cA + (size_t)(t + 1) * kstep;
            const char* a2 = last ? nA : cA + (size_t)(t + 2) * kstep; const char* b2 = last ? nB : cB + (size_t)(t + 2) * kstep;
            const char* a3 = a2 + kstep; const char* b3 = b2 + kstep;
            PG8_LDB(B0, 0, 0); PG8_LDB(B1, 0, 1); PG8_SCHED; PG8_LDA(At, 0, 0); PG8_STAGE(PG8_SA(1, 1), a1 + hstepA, offA);
            PG8_WAIT_V(8); PG8_WAIT_L(0); PG8_BAR; PG8_MMA(0, 0, At, B0); PG8_MMA(0, 1, At, B1); PG8_BAR; PG8_SCHED;
            PG8_LDA(At, 0, 1); PG8_STAGE(PG8_SB(0, 0), b2, offB); PG8_STAGE(PG8_SB(0, 1), b2 + hstepB, offB); PG8_STAGE(PG8_SA(0, 0), a2, offA);
            PG8_WAIT_V(8); PG8_WAIT_L(0); PG8_BAR; PG8_MMA(1, 0, At, B0); PG8_MMA(1, 1, At, B1); PG8_BAR; PG8_SCHED;
            PG8_LDB(B0, 1, 0); PG8_LDB(B1, 1, 1); PG8_SCHED; PG8_LDA(At, 1, 0); PG8_STAGE(PG8_SA(0, 1), a2 + hstepA, offA);
            PG8_WAIT_V(8); PG8_WAIT_L(0); PG8_BAR; PG8_MMA(0, 0, At, B0); PG8_MMA(0, 1, At, B1); PG8_BAR; PG8_SCHED;
            PG8_LDA(At, 1, 1); PG8_STAGE(PG8_SB(1, 0), b3, offB); PG8_STAGE(PG8_SB(1, 1), b3 + hstepB, offB); PG8_STAGE(PG8_SA(1, 0), a3, offA);
            PG8_WAIT_V(8); PG8_WAIT_L(0); PG8_BAR; PG8_MMA(1, 0, At, B0); PG8_MMA(1, 1, At, B1); PG8_BAR; PG8_SCHED;
        }
        if (wr == 0) PG8_BAR;
        { int l2; asm volatile("v_mbcnt_lo_u32_b32 %0, -1, 0\n\tv_mbcnt_hi_u32_b32 %0, -1, %0" : "=v"(l2));
          E(acc, cur, wr, wc, l2 & 15, l2 >> 4); }
        if (!has_next) break;
        if (nxt.first) {
#pragma unroll
        for (int a = 0; a < 2; ++a)
#pragma unroll
            for (int b = 0; b < 2; ++b)
#pragma unroll
                for (int m = 0; m < 4; ++m)
#pragma unroll
                    for (int n = 0; n < 2; ++n) acc[a][b][m][n] = (f32x4){0.f, 0.f, 0.f, 0.f};
        }
        cur = nxt; cA = nA; cB = nB; ++ui;
        if (wr == 1) PG8_BAR;
    }
    PG8_WAIT_V(0);
    PG8_BAR;
#undef d64offA
#undef d64offB
#undef PG8_SA
#undef PG8_SB
#undef PG8_STAGE
#undef PG8_LDA
#undef PG8_LDB
#undef PG8_MMA
#undef PG8_WAIT_V
#undef PG8_WAIT_L
#undef PG8_BAR
#undef PG8_SCHED
}

struct SchedStd {
    int nM, nN, G, c, lda, ldb, nt;
    __device__ __forceinline__ bool next(int i, Unit& u) const {
        const long L = (long)i * G + c; if (L >= (long)nM * nN) return false;
        int pm, pn; tile_map((int)L, nM, nN, pm, pn);
        u.first = 1; u.pm = pm; u.pn = pn; u.aux = 0; u.nt = nt; u.aoff = (size_t)pm * 256 * lda * 2; u.boff = (size_t)pn * 256 * ldb * 2; return true;
    }
};
struct SchedPre {
    int G, c;
    __device__ __forceinline__ bool next(int i, Unit& u) const {
        const int L = i * G + c; if (L >= 32) return false;
        const int pm = L & 7, gi = L >> 3;
        u.first = 1; u.pm = pm; u.pn = gi; u.aux = 0; u.nt = 4; u.aoff = ((size_t)pm * 256 * 1024 + gi * 256) * 2; u.boff = (size_t)gi * 65536 * 2; return true;
    }
};
struct SchedInner {
    int G, c;
    __device__ __forceinline__ bool next(int i, Unit& u) const {
        int L = i * G + c; if (L >= 128) return false;
        if (G == 224) L = (((c & 7) >> 1) << 5) | ((c & 1) << 4) | (c >> 3);
        const int h = L & 3, pm = L >> 2;
        u.first = 1; u.pm = pm; u.pn = 0; u.aux = h; u.nt = 4; u.aoff = ((size_t)pm * 256 * 1024 + h * 256) * 2; u.boff = u.aoff; return true;
    }
};
struct SchedChain {
    int c;
    __device__ __forceinline__ bool next(int i, Unit& u) const {
        if (i >= 7) return false;
        const int cq = (((c & 7) >> 1) << 3) | ((c & 1) << 2) | (c >> 3);
        const int dvh = cq & 1, bh = cq >> 1, b = bh >> 2, h = bh & 3, cc = i;
        u.first = (i == 0); u.pm = (bh * 8 + cc) * 2 + dvh; u.pn = cc; u.aux = h; u.nt = 4;
        u.aoff = ((size_t)((bh * 8 + cc) * 512 + dvh * 256) * 512) * 2;
        u.boff = ((size_t)((b * 8 + cc) * 256) * 1024 + h * 256) * 2; return true;
    }
};
struct SchedO {
    int G, c;
    __device__ __forceinline__ bool next(int i, Unit& u) const {
        int L = i * G + c; if (L >= 256) return false;
        if (G == 256) L = ((c & 6) << 5) | ((c & 1) << 5) | (c >> 3);
        const int dvh = L & 1, h = (L >> 1) & 3, cc = (L >> 3) & 7, b = L >> 6;
        u.first = 1; u.pm = b * 8 + cc; u.pn = dvh; u.aux = h; u.nt = cc == 0 ? 4 : 8;
        u.aoff = ((size_t)(b * 8 + cc) * 256 * 2048 + h * 512) * 2;
        u.boff = ((size_t)(((b * 4 + h) * 8 + cc) * 512 + dvh * 256) * 512) * 2; return true;
    }
};
struct SchedCat {
    int G, c;
    __device__ __forceinline__ bool next(int i, Unit& u) const {
        const int T = (i / 6) * G + c, u6 = i % 6; if (T >= 256) return false;
        int pm, pn; tile_map(T, 32, 8, pm, pn);
        const int k0 = u6 == 0 ? 0 : (u6 == 1 ? 1024 : 2048 + (u6 - 2) * 512);
        u.first = (u6 == 0); u.pm = pm; u.pn = pn; u.aux = u6; u.nt = u6 < 2 ? 16 : 8;
        u.aoff = ((size_t)pm * 256 * 4096 + k0) * 2; u.boff = ((size_t)pn * 256 * 4096 + k0) * 2; return true;
    }
};

typedef const f32x4 (&AccRef)[2][2][4][2];

struct EpiSwiglu {
    static constexpr bool PERM = true;
    bf16_t* ACT; const float* RINV;
    __device__ __forceinline__ void operator()(AccRef acc, const Unit& u, int wr, int wc, int fr, int fq) const {
#pragma unroll
        for (int ai = 0; ai < 2; ++ai)
#pragma unroll
            for (int m = 0; m < 4; ++m) {
                const int row = u.pm * 256 + ai * 128 + wr * 64 + m * 16 + fr; const float rs = RINV[row];
                float a[8];
#pragma unroll
                for (int n = 0; n < 2; ++n)
#pragma unroll
                    for (int e = 0; e < 4; ++e) { const float gv = acc[ai][0][m][n][e] * rs, uv = acc[ai][1][m][n][e] * rs; a[n * 4 + e] = fast_silu(gv) * uv; }
                u32x4 w; w.x = cvt_pk_bf16(a[0], a[1]); w.y = cvt_pk_bf16(a[2], a[3]); w.z = cvt_pk_bf16(a[4], a[5]); w.w = cvt_pk_bf16(a[6], a[7]);
                *(u32x4*)(ACT + (size_t)row * FF + u.pn * 128 + wc * 32 + fq * 8) = w;
            }
    }
};
struct EpiYssq {
    static constexpr bool PERM = true, AFTER_DRAIN = false;
    bf16_t* Y; float* SSQ;
    __device__ __forceinline__ void operator()(AccRef acc, const Unit& u, int wr, int wc, int fr, int fq) const {
#pragma unroll
        for (int ai = 0; ai < 2; ++ai)
#pragma unroll
            for (int m = 0; m < 4; ++m) {
                const int row = u.pm * 256 + ai * 128 + wr * 64 + m * 16 + fr; float s = 0.f;
                bf16_t* rowp = Y + (size_t)row * DM + u.pn * 256 + wc * 32 + fq * 8;
#pragma unroll
                for (int bj = 0; bj < 2; ++bj) { const f32x4 v0 = acc[ai][bj][m][0], v1 = acc[ai][bj][m][1];
                    u32x4 w; w.x = cvt_pk_bf16(v0[0], v0[1]); w.y = cvt_pk_bf16(v0[2], v0[3]); w.z = cvt_pk_bf16(v1[0], v1[1]); w.w = cvt_pk_bf16(v1[2], v1[3]);
                    *(u32x4*)(rowp + bj * 128) = w;
                    s += (v0[0] * v0[0] + v0[1] * v0[1]) + (v0[2] * v0[2] + v0[3] * v0[3]) + (v1[0] * v1[0] + v1[1] * v1[1]) + (v1[2] * v1[2] + v1[3] * v1[3]); }
                s += __shfl_xor(s, 16); s += __shfl_xor(s, 32);
                if (fq == 0) SSQ[(size_t)row * 32 + u.pn * 4 + wc] = s;
            }
    }
};
struct EpiPre {
    static constexpr bool PERM = true;
    bf16_t* WCAT;
    __device__ __forceinline__ void operator()(AccRef acc, const Unit& u, int wr, int wc, int fr, int fq) const {
#pragma unroll
        for (int ai = 0; ai < 2; ++ai)
#pragma unroll
            for (int m = 0; m < 4; ++m) {
                const int row = u.pm * 256 + ai * 128 + wr * 64 + m * 16 + fr;
#pragma unroll
                for (int bj = 0; bj < 2; ++bj) { const f32x4 v0 = acc[ai][bj][m][0], v1 = acc[ai][bj][m][1];
                    u32x4 w; w.x = cvt_pk_bf16(v0[0], v0[1]); w.y = cvt_pk_bf16(v0[2], v0[3]); w.z = cvt_pk_bf16(v1[0], v1[1]); w.w = cvt_pk_bf16(v1[2], v1[3]);
                    *(u32x4*)(WCAT + (size_t)row * 4096 + u.pn * 256 + bj * 128 + wc * 32 + fq * 8) = w; }
            }
    }
};
struct EpiInner {
    static constexpr bool PERM = true;
    bf16_t* RA;
    __device__ __forceinline__ void operator()(AccRef acc, const Unit& u, int wr, int wc, int fr, int fq) const {
        const int h = u.aux; const float lg = ret_lg(h);
#pragma unroll
        for (int ai = 0; ai < 2; ++ai)
#pragma unroll
            for (int m = 0; m < 4; ++m) {
                int i = ai * 128 + wr * 64 + m * 16 + fr; asm volatile("" : "+v"(i)); const int row = u.pm * 256 + i;
                float lgm = lg; asm volatile("" : "+v"(lgm));
#pragma unroll
                for (int bj = 0; bj < 2; ++bj) { const int cb = bj * 128 + wc * 32 + fq * 8; float a[8];
#pragma unroll
                    for (int n = 0; n < 2; ++n)
#pragma unroll
                        for (int e = 0; e < 4; ++e) { const int d = i - (cb + n * 4 + e); const float dec = __builtin_amdgcn_exp2f((float)d * lgm); a[n * 4 + e] = d >= 0 ? acc[ai][bj][m][n][e] * dec : 0.f; }
                    u32x4 w; w.x = cvt_pk_bf16(a[0], a[1]); w.y = cvt_pk_bf16(a[2], a[3]); w.z = cvt_pk_bf16(a[4], a[5]); w.w = cvt_pk_bf16(a[6], a[7]);
                    *(u32x4*)(RA + (size_t)row * 2048 + h * 512 + cb) = w; __builtin_amdgcn_sched_barrier(0); }
            }
    }
};
struct EpiChain {
    static constexpr bool PERM = true;
    bf16_t* RB;
    __device__ __forceinline__ void operator()(f32x4 (&acc)[2][2][4][2], const Unit& u, int wr, int wc, int fr, int fq) const {
        const float cd = exp2f(256.0f * ret_lg(u.aux));
#pragma unroll
        for (int ai = 0; ai < 2; ++ai)
#pragma unroll
            for (int m = 0; m < 4; ++m) {
                const size_t row = (size_t)(u.pm + 2) * 256 + ai * 128 + wr * 64 + m * 16 + fr;
#pragma unroll
                for (int bj = 0; bj < 2; ++bj) { const f32x4 v0 = acc[ai][bj][m][0], v1 = acc[ai][bj][m][1];
                    u32x4 w; w.x = cvt_pk_bf16(v0[0], v0[1]); w.y = cvt_pk_bf16(v0[2], v0[3]); w.z = cvt_pk_bf16(v1[0], v1[1]); w.w = cvt_pk_bf16(v1[2], v1[3]);
                    *(u32x4*)(RB + row * 512 + 256 + bj * 128 + wc * 32 + fq * 8) = w;
                    acc[ai][bj][m][0] = v0 * cd; acc[ai][bj][m][1] = v1 * cd; }
            }
    }
};
struct EpiO {
    static constexpr bool PERM = true;
    bf16_t* ACAT; const bf16_t* SG; float* SSQO;
    __device__ __forceinline__ void operator()(AccRef acc, const Unit& u, int wr, int wc, int fr, int fq) const {
        const int h = u.aux, dvh = u.pn;
#pragma unroll
        for (int ai = 0; ai < 2; ++ai)
#pragma unroll
            for (int m = 0; m < 4; ++m) {
                const int row = u.pm * 256 + ai * 128 + wr * 64 + m * 16 + fr; float s = 0.f;
#pragma unroll
                for (int bj = 0; bj < 2; ++bj) { const int cg = h * 512 + dvh * 256 + bj * 128 + wc * 32 + fq * 8;
                    const u32x4 sg = *(const u32x4*)(SG + (size_t)row * 2048 + cg);
                    const f32x4 v0 = acc[ai][bj][m][0], v1 = acc[ai][bj][m][1];
                    s += (v0[0] * v0[0] + v0[1] * v0[1]) + (v0[2] * v0[2] + v0[3] * v0[3]) + (v1[0] * v1[0] + v1[1] * v1[1]) + (v1[2] * v1[2] + v1[3] * v1[3]);
                    u32x4 w; w.x = cvt_pk_bf16(v0[0] * bf_lo(sg.x), v0[1] * bf_hi(sg.x)); w.y = cvt_pk_bf16(v0[2] * bf_lo(sg.y), v0[3] * bf_hi(sg.y));
                    w.z = cvt_pk_bf16(v1[0] * bf_lo(sg.z), v1[1] * bf_hi(sg.z)); w.w = cvt_pk_bf16(v1[2] * bf_lo(sg.w), v1[3] * bf_hi(sg.w));
                    *(u32x4*)(ACAT + (size_t)row * 4096 + 2048 + cg) = w; }
                s += __shfl_xor(s, 16); s += __shfl_xor(s, 32);
                if (fq == 0) SSQO[((size_t)row * 4 + h) * 8 + dvh * 4 + wc] = s;
            }
    }
};
struct EpiCat {
    static constexpr bool PERM = true;
    bf16_t* MB; const bf16_t* G; const float* SSQO;
    __device__ __forceinline__ float rinv_o(int row, int h) const {
        const f32x4 p0 = *(const f32x4*)(SSQO + ((size_t)row * 4 + h) * 8), p1 = *(const f32x4*)(SSQO + ((size_t)row * 4 + h) * 8 + 4);
        const float ss = ((p0[0] + p0[1]) + (p0[2] + p0[3])) + ((p1[0] + p1[1]) + (p1[2] + p1[3])); return rsqrtf(ss * (1.0f / 512.0f) + EPS); }
    static __device__ __forceinline__ void unpack8(const u32x4 w, float (&f)[8]) { f[0] = bf_lo(w.x); f[1] = bf_hi(w.x); f[2] = bf_lo(w.y); f[3] = bf_hi(w.y); f[4] = bf_lo(w.z); f[5] = bf_hi(w.z); f[6] = bf_lo(w.w); f[7] = bf_hi(w.w); }
    __device__ __forceinline__ void operator()(f32x4 (&acc)[2][2][4][2], const Unit& u, int wr, int wc, int fr, int fq) const {
        const int u6 = u.aux;
#pragma unroll
        for (int ai = 0; ai < 2; ++ai)
#pragma unroll
            for (int m = 0; m < 4; ++m) {
                const int row = u.pm * 256 + ai * 128 + wr * 64 + m * 16 + fr;
                float rs_cur = 1.f, rs_nxt = 1.f;
                if (u6 >= 2) rs_cur = rinv_o(row, u6 - 2);
                if (u6 >= 1 && u6 <= 4) rs_nxt = rinv_o(row, u6 - 1);
                const bf16_t* grow = G + (size_t)row * 6144 + u.pn * 256 + wc * 32 + fq * 8;
#pragma unroll
                for (int bj = 0; bj < 2; ++bj) { const int cl = bj * 128;
                    float sc[8];
                    if (u6 == 0) { float gp[8], ga[8]; unpack8(*(const u32x4*)(grow + cl), gp); unpack8(*(const u32x4*)(grow + 2048 + cl), ga);
#pragma unroll
                        for (int e = 0; e < 8; ++e) sc[e] = gp[e] * __builtin_amdgcn_rcpf(ga[e]); }
                    else if (u6 == 1) { float ga[8], gr[8]; unpack8(*(const u32x4*)(grow + 2048 + cl), ga); unpack8(*(const u32x4*)(grow + 4096 + cl), gr);
#pragma unroll
                        for (int e = 0; e < 8; ++e) sc[e] = ga[e] * __builtin_amdgcn_rcpf(gr[e] * rs_nxt); }
                    else if (u6 < 5) { const float s1 = rs_cur * __builtin_amdgcn_rcpf(rs_nxt);
#pragma unroll
                        for (int e = 0; e < 8; ++e) sc[e] = s1; }
                    else { float gr[8]; unpack8(*(const u32x4*)(grow + 4096 + cl), gr);
#pragma unroll
                        for (int e = 0; e < 8; ++e) sc[e] = gr[e] * rs_cur; }
                    f32x4 v0 = acc[ai][bj][m][0], v1 = acc[ai][bj][m][1];
                    v0[0] *= sc[0]; v0[1] *= sc[1]; v0[2] *= sc[2]; v0[3] *= sc[3]; v1[0] *= sc[4]; v1[1] *= sc[5]; v1[2] *= sc[6]; v1[3] *= sc[7];
                    if (u6 < 5) { acc[ai][bj][m][0] = v0; acc[ai][bj][m][1] = v1; }
                    else { u32x4 w; w.x = cvt_pk_bf16(v0[0], v0[1]); w.y = cvt_pk_bf16(v0[2], v0[3]); w.z = cvt_pk_bf16(v1[0], v1[1]); w.w = cvt_pk_bf16(v1[2], v1[3]);
                        *(u32x4*)(MB + (size_t)row * DM + u.pn * 256 + wc * 32 + fq * 8 + cl) = w; }
                }
            }
    }
};
struct EpiInproj {
    static constexpr bool PERM = true;
    const float* RINV; bf16_t *XP, *Q, *KB, *VT, *RQ, *RK, *RA, *RKT, *RB, *SG, *G;
    __device__ __forceinline__ void operator()(AccRef acc, const Unit& u, int wr, int wc, int fr, int fq) const {
        const int pn = u.pn, pm = u.pm, b = pm >> 3, cc = pm & 7;
        int kind, hh = 0; bf16_t* dst = nullptr; int pitch = 0, cofs = 0;
        if (pn < 4) { kind = 0; dst = XP; pitch = 1024; cofs = pn * 256; }
        else if (pn < 8) { kind = 0; dst = Q; pitch = 1024; cofs = (pn - 4) * 256; }
        else if (pn == 8) { kind = 0; dst = KB; pitch = 256; cofs = 0; }
        else if (pn == 9) { kind = 1; }
        else if (pn < 14) { kind = 2; hh = pn - 10; }
        else if (pn < 18) { kind = 3; hh = pn - 14; }
        else if (pn < 26) { kind = 4; hh = (pn - 18) >> 1; }
        else if (pn < 34) { kind = 5; dst = SG; pitch = 2048; cofs = (pn - 26) * 256; }
        else { kind = 6; dst = G; pitch = 6144; cofs = (pn - 34) * 256; }
        const float lg = ret_lg(hh);
#pragma unroll
        for (int ai = 0; ai < 2; ++ai)
#pragma unroll
            for (int m = 0; m < 4; ++m) {
                int rl = ai * 128 + wr * 64 + m * 16 + fr; asm volatile("" : "+v"(rl)); const int row = pm * 256 + rl; const float rs = RINV[row];
                float lgm = lg; asm volatile("" : "+v"(lgm));
#pragma unroll
                for (int bj = 0; bj < 2; ++bj) { const int cb = bj * 128 + wc * 32 + fq * 8; float a[8];
#pragma unroll
                    for (int n = 0; n < 2; ++n)
#pragma unroll
                        for (int e = 0; e < 4; ++e) a[n * 4 + e] = acc[ai][bj][m][n][e] * rs;
                    if (kind == 0 || kind == 5 || kind == 6) {
                        if (kind == 5) {
#pragma unroll
                            for (int e = 0; e < 8; ++e) a[e] = fast_silu(a[e]); }
                        if (kind == 6) {
#pragma unroll
                            for (int e = 0; e < 8; ++e) a[e] = fast_sigmoid(a[e]); }
                        u32x4 w; w.x = cvt_pk_bf16(a[0], a[1]); w.y = cvt_pk_bf16(a[2], a[3]); w.z = cvt_pk_bf16(a[4], a[5]); w.w = cvt_pk_bf16(a[6], a[7]);
                        *(u32x4*)(dst + (size_t)row * pitch + cofs + cb) = w;
                    } else if (kind == 1) {
#pragma unroll
                        for (int e = 0; e < 8; ++e) { const int col = cb + e; VT[((size_t)(b * 4 + (col >> 6)) * 64 + (col & 63)) * SEQ + cc * 256 + (rl & ~15) + ((rl & 3) | (((rl >> 3) & 1) << 2) | (((rl >> 2) & 1) << 3))] = (bf16_t)(cvt_pk_bf16(a[e], 0.f) & 0xffffu); }
                    } else if (kind == 2) {
                        const float qd = __builtin_amdgcn_exp2f((float)(rl + 1) * lgm);
                        u32x4 w; w.x = cvt_pk_bf16(a[0], a[1]); w.y = cvt_pk_bf16(a[2], a[3]); w.z = cvt_pk_bf16(a[4], a[5]); w.w = cvt_pk_bf16(a[6], a[7]);
                        *(u32x4*)(RQ + (size_t)row * 1024 + hh * 256 + cb) = w;
                        w.x = cvt_pk_bf16(a[0] * qd, a[1] * qd); w.y = cvt_pk_bf16(a[2] * qd, a[3] * qd); w.z = cvt_pk_bf16(a[4] * qd, a[5] * qd); w.w = cvt_pk_bf16(a[6] * qd, a[7] * qd);
                        *(u32x4*)(RA + (size_t)row * 2048 + hh * 512 + 256 + cb) = w;
                    } else if (kind == 3) {
                        const float kd = __builtin_amdgcn_exp2f((float)(255 - rl) * lgm);
#pragma unroll
                        for (int e = 0; e < 8; ++e) a[e] *= 0.0625f;
                        u32x4 w; w.x = cvt_pk_bf16(a[0], a[1]); w.y = cvt_pk_bf16(a[2], a[3]); w.z = cvt_pk_bf16(a[4], a[5]); w.w = cvt_pk_bf16(a[6], a[7]);
                        *(u32x4*)(RK + (size_t)row * 1024 + hh * 256 + cb) = w;
#pragma unroll
                        for (int e = 0; e < 8; ++e) RKT[((size_t)pm * 256 + cb + e) * 1024 + hh * 256 + rl] = (bf16_t)(cvt_pk_bf16(a[e] * kd, 0.f) & 0xffffu);
                    } else {
                        const int dv0 = ((pn - 18) & 1) * 256 + cb;
#pragma unroll
                        for (int e = 0; e < 8; ++e) RB[((size_t)((b * 4 + hh) * 8 + cc) * 512 + dv0 + e) * 512 + rl] = (bf16_t)(cvt_pk_bf16(a[e], 0.f) & 0xffffu);
                    }
                }
            }
    }
};
}


#define XB_TMO      128
#define XB_XCNT(j)  (256  + 64 * (j))
#define XB_XSUB(j)  (1280 + 64 * (j))
#define XB_XGEN(j)  (2304 + 64 * (j))
#define XB_TOP      3328
#define XB_TOPGEN   3392
#define XCD_BAR_WORDS 3456
#define XB_SPIN_CAP (1u << 18)
__device__ __forceinline__ unsigned xb_ld(unsigned* p)              { return __hip_atomic_load(p, __ATOMIC_RELAXED, __HIP_MEMORY_SCOPE_AGENT); }
__device__ __forceinline__ unsigned xb_add(unsigned* p, unsigned v) { return __hip_atomic_fetch_add(p, v, __ATOMIC_RELAXED, __HIP_MEMORY_SCOPE_AGENT); }
__device__ __forceinline__ unsigned xb_xcc_id() { return (unsigned)__builtin_amdgcn_s_getreg((3 << 11) | 20) & 0xFu; }
#define XB_SPIN(cond, bar) do { unsigned _sp = 0; while (cond) { __builtin_amdgcn_s_sleep(1); \
    if ((++_sp & 255u) == 0u) { if (xb_ld(&(bar)[XB_TMO])) break; if (_sp > XB_SPIN_CAP) { atomicAdd(&(bar)[XB_TMO], 1u); break; } } } } while (0)
__device__ __forceinline__ void xcd_barrier_complete(unsigned* bar, unsigned x, unsigned& nloc, unsigned& nx) {
    const unsigned G = gridDim.x * gridDim.y * gridDim.z;
    unsigned sum, cnt, mine, sp = 0u;
    for (;;) {
        sum = 0u; cnt = 0u; mine = 0u;
#pragma unroll
        for (unsigned j = 0; j < 16; ++j) { const unsigned c = xb_ld(&bar[XB_XCNT(j)]); sum += c; cnt += (c > 0u) ? 1u : 0u; mine = (j == x) ? c : mine; }
        if (sum == G) break;
        __builtin_amdgcn_s_sleep(1);
        if ((++sp & 255u) == 0u) { if (xb_ld(&bar[XB_TMO])) break; if (sp > XB_SPIN_CAP) { atomicAdd(&bar[XB_TMO], 1u); break; } }
    }
    nloc = mine > 0u ? mine : 1u; nx = cnt > 0u ? cnt : 1u;
}
__device__ __forceinline__ void xcd_barrier(unsigned* bar, volatile LAS unsigned* st) {
    asm volatile("s_waitcnt vmcnt(0)" ::: "memory");
    __syncthreads();
    if (threadIdx.x == 0) {
        const unsigned x = xb_xcc_id();
        __builtin_amdgcn_s_waitcnt(0);
        unsigned nloc = st[0], nx = st[1];
        if (nloc == 0u) { xcd_barrier_complete(bar, x, nloc, nx); st[0] = nloc; st[1] = nx; }
        const unsigned old = xb_add(&bar[XB_XSUB(x)], 1u);
        const unsigned gen = old / nloc;
        if (old + 1u == (gen + 1u) * nloc) {
            __builtin_amdgcn_fence(__ATOMIC_RELEASE, "agent");
            asm volatile("s_waitcnt vmcnt(0)" ::: "memory");
            const unsigned og = xb_add(&bar[XB_TOP], 1u);
            const unsigned tg = og / nx;
            if (og + 1u == (tg + 1u) * nx) xb_add(&bar[XB_TOPGEN], 1u);
            else XB_SPIN(xb_ld(&bar[XB_TOPGEN]) == tg, bar);
            __builtin_amdgcn_fence(__ATOMIC_ACQUIRE, "agent");
            xb_add(&bar[XB_XGEN(x)], 1u);
            asm volatile("s_waitcnt vmcnt(0)" ::: "memory");
        } else {
            XB_SPIN(xb_ld(&bar[XB_XGEN(x)]) == gen, bar);
            __builtin_amdgcn_fence(__ATOMIC_ACQUIRE, "agent");
            asm volatile("s_waitcnt vmcnt(0)" ::: "memory");
        }
    }
    __syncthreads();
}

struct Args { const float* in[21]; float* out; unsigned char* ws; int ph_lo, ph_hi, coop, pad; };
typedef const __attribute__((address_space(4))) Args* ArgsP;

struct ConvDesc { const float* W; const float* kscale; bf16_t* dst; int K, N, ldd, coloff, rowoff, swiglu, item; };
__device__ __forceinline__ void conv_load(const ConvDesc& d, int lane, f32x4 (&v)[16], float (&sc)[16]) {
    const int nblk = d.N >> 6, kb = d.item / nblk, nb = d.item - kb * nblk, k0 = kb * 64, n0 = nb * 64, kr = lane >> 4, n = 4 * (lane & 15);
#pragma unroll
    for (int i = 0; i < 16; ++i) { v[i] = __builtin_nontemporal_load((const f32x4*)(d.W + (size_t)(k0 + 4 * i + kr) * d.N + n0 + n)); sc[i] = d.kscale ? d.kscale[k0 + 4 * i + kr] : 1.0f; }
}
__device__ __forceinline__ void conv_store(const ConvDesc& d, LAS float* scr, int lane, const f32x4 (&v)[16], const float (&sc)[16]) {
    const int nblk = d.N >> 6, kb = d.item / nblk, nb = d.item - kb * nblk, k0 = kb * 64, n0 = nb * 64, kr = lane >> 4, n = 4 * (lane & 15);
#pragma unroll
    for (int i = 0; i < 16; ++i) { LAS float* s = scr + (4 * i + kr) * 65 + n; s[0] = v[i][0] * sc[i]; s[1] = v[i][1] * sc[i]; s[2] = v[i][2] * sc[i]; s[3] = v[i][3] * sc[i]; }
    asm volatile("s_waitcnt lgkmcnt(0)" ::: "memory");
    const int c = lane & 7;
#pragma unroll
    for (int j = 0; j < 8; ++j) { const int nn = (lane >> 3) + 8 * j; const LAS float* s = scr + (8 * c) * 65 + nn;
        u32x4 o; o.x = cvt_pk_bf16(s[0 * 65], s[1 * 65]); o.y = cvt_pk_bf16(s[2 * 65], s[3 * 65]); o.z = cvt_pk_bf16(s[4 * 65], s[5 * 65]); o.w = cvt_pk_bf16(s[6 * 65], s[7 * 65]);
        int sn = n0 + nn, drow;
        if (d.swiglu) { const int bj = sn >= FF ? 1 : 0, jj = sn - bj * FF; drow = ((jj >> 7) << 8) + bj * 128 + (jj & 127); } else drow = d.rowoff + sn;
        *(u32x4*)(d.dst + (size_t)drow * d.ldd + d.coloff + k0 + 8 * c) = o; }
    asm volatile("s_waitcnt lgkmcnt(0)" ::: "memory");
}
__device__ __forceinline__ ConvDesc conv_decode(ArgsP ap, int l, int it) {
    unsigned char* ws = ap->ws;
    constexpr int I_UP = 32 * 176, I_DN = 88 * 32, I_IN = 32 * 136, I_GT = 32 * 96, I_AO = 16 * 32, I_RO = 32 * 32, I_WO = 32 * 32;
    int r = it;
    if (r < I_UP) return ConvDesc{ap->in[2] + (size_t)l * DM * 2 * FF, ap->in[1] + l * DM, (bf16_t*)(ws + WS_WUP1), DM, 2 * FF, DM, 0, 0, 1, r}; r -= I_UP;
    if (r < I_UP) return ConvDesc{ap->in[18] + (size_t)l * DM * 2 * FF, ap->in[17] + l * DM, (bf16_t*)(ws + WS_WUP2), DM, 2 * FF, DM, 0, 0, 1, r}; r -= I_UP;
    if (r < I_DN) return ConvDesc{ap->in[3] + (size_t)l * FF * DM, nullptr, (bf16_t*)(ws + WS_WDN1), FF, DM, FF, 0, 0, 0, r}; r -= I_DN;
    if (r < I_DN) return ConvDesc{ap->in[19] + (size_t)l * FF * DM, nullptr, (bf16_t*)(ws + WS_WDN2), FF, DM, FF, 0, 0, 0, r}; r -= I_DN;
    if (r < I_IN) return ConvDesc{ap->in[6] + (size_t)l * DM * 8704, ap->in[5] + l * DM, (bf16_t*)(ws + WS_WIN), DM, 8704, DM, 0, 0, 0, r}; r -= I_IN;
    if (r < I_GT) return ConvDesc{ap->in[14] + (size_t)l * DM * 6144, ap->in[5] + l * DM, (bf16_t*)(ws + WS_WIN), DM, 6144, DM, 0, 8704, 0, r}; r -= I_GT;
    if (r < I_AO) return ConvDesc{ap->in[12] + (size_t)l * 1024 * DM, nullptr, (bf16_t*)(ws + WS_WCAT), 1024, DM, 4096, 1024, 0, 0, r}; r -= I_AO;
    if (r < I_RO) return ConvDesc{ap->in[13] + (size_t)l * 2048 * DM, ap->in[10] + l * 2048, (bf16_t*)(ws + WS_WCAT), 2048, DM, 4096, 2048, 0, 0, r}; r -= I_RO;
    if (r < I_WO) return ConvDesc{ap->in[15] + (size_t)l * DM * DM, nullptr, (bf16_t*)(ws + WS_WOUT), DM, DM, DM, 0, 0, 0, r}; r -= I_WO;
    return ConvDesc{ap->in[11] + (size_t)l * 1024 * DM, ap->in[8] + l * 1024, (bf16_t*)(ws + WS_WPOT), 1024, DM, 1024, 0, 0, 0, r};
}
__device__ __forceinline__ void prep_layer(ArgsP ap, int l, LAS unsigned char* lds, int gw, int NGW, int wave, int lane) {
    LAS float* scr = (LAS float*)(lds + wave * 16640);
    constexpr int NIT = 2 * (32 * 176) + 2 * (88 * 32) + 32 * 136 + 32 * 96 + 16 * 32 + 32 * 32 + 32 * 32 + 16 * 32;
    if (gw < NIT) {
        int it = gw;
        ConvDesc dA = conv_decode(ap, l, it), dB = dA;
        f32x4 vA[16], vB[16]; float sA[16], sB[16];
        conv_load(dA, lane, vA, sA);
        for (;;) {
            it += NGW; const bool more1 = it < NIT;
            if (more1) { dB = conv_decode(ap, l, it); conv_load(dB, lane, vB, sB); }
            conv_store(dA, scr, lane, vA, sA);
            if (!more1) break;
            it += NGW; const bool more2 = it < NIT;
            if (more2) { dA = conv_decode(ap, l, it); conv_load(dA, lane, vA, sA); }
            conv_store(dB, scr, lane, vB, sB);
            if (!more2) break;
        }
    }
    const float* pw = ap->in[7] + (size_t)l * 262144; bf16_t* pg = (bf16_t*)(ap->ws + WS_WPG);
    for (int i = gw * 64 + lane; i < 65536; i += NGW * 64) { const f32x4 v = *(const f32x4*)(pw + (size_t)i * 4); u32x2 w; w.x = cvt_pk_bf16(v[0], v[1]); w.y = cvt_pk_bf16(v[2], v[3]); *(u32x2*)(pg + (size_t)i * 4) = w; }
}

__device__ __forceinline__ float wave_sum(float v) {
#pragma unroll
    for (int o = 1; o < 64; o <<= 1) v += __shfl_xor(v, o);
    return v;
}
__device__ __forceinline__ void rowpass(int src, int fin, const float* x, const bf16_t* Y, const float* SSQ, const float* post, float coef, float* OUT, bf16_t* HBF, float* RINV, int gw, int NGW, int rend, int lane) {
    for (int row0 = gw; row0 < rend; row0 += 2 * NGW) {
        f32x4 v[2][8]; float s2[2];
#pragma unroll
        for (int q = 0; q < 2; ++q) {
            const int row = row0 + q * NGW;
            const bool ok = row < rend; const int rr = ok ? row : row0;
            float ry = 0.f;
            if (src) { const float p = SSQ[(size_t)rr * 32 + (lane & 31)]; float s = p;
#pragma unroll
                for (int o = 1; o < 32; o <<= 1) s += __shfl_xor(s, o);
                ry = rsqrtf(s * (1.0f / DM) + EPS) * coef; }
            const f32x4* xp = (const f32x4*)(x + (size_t)rr * DM) + lane; const u32x2* yp = (const u32x2*)(Y + (size_t)rr * DM) + lane; const f32x4* pp = (const f32x4*)post + lane;
            const u32x2* bp = (const u32x2*)(HBF + (size_t)rr * DM) + lane;
            float acc2 = 0.f;
#pragma unroll
            for (int j = 0; j < 8; ++j) {
                f32x4 t;
                if (src == 2) { const u32x2 hw = bp[64 * j]; t = (f32x4){bf_lo(hw.x), bf_hi(hw.x), bf_lo(hw.y), bf_hi(hw.y)}; } else t = xp[64 * j];
                if (src) { const u32x2 yw = yp[64 * j]; const f32x4 y = (f32x4){bf_lo(yw.x), bf_hi(yw.x), bf_lo(yw.y), bf_hi(yw.y)}, g = pp[64 * j]; t += y * g * ry; }
                acc2 += (t[0] * t[0] + t[1] * t[1]) + (t[2] * t[2] + t[3] * t[3]); v[q][j] = t; }
            s2[q] = acc2;
        }
#pragma unroll
        for (int q = 0; q < 2; ++q) {
            const int row = row0 + q * NGW; if (row >= rend) continue;
            const float tot = wave_sum(s2[q]);
            if (fin) { f32x4* op = (f32x4*)(OUT + (size_t)row * DM) + lane;
#pragma unroll
                for (int j = 0; j < 8; ++j) op[64 * j] = v[q][j]; }
            else { u32x2* bp = (u32x2*)(HBF + (size_t)row * DM) + lane;
#pragma unroll
                for (int j = 0; j < 8; ++j) { u32x2 w; w.x = cvt_pk_bf16(v[q][j][0], v[q][j][1]); w.y = cvt_pk_bf16(v[q][j][2], v[q][j][3]); bp[64 * j] = w; }
                if (lane == 0) RINV[row] = rsqrtf(tot * (1.0f / DM) + EPS); }
        }
    }
}

__device__ __forceinline__ void pool_phase(const bf16_t* XP, bf16_t* ACAT, int gtid, int NT, int iend) {
    for (int it = gtid; it < iend; it += NT) {
        const int row = it >> 7, c0 = (it & 127) * 8, w = 2 << (c0 >> 8), t = row & (SEQ - 1), cnt = (t + 1) < w ? (t + 1) : w;
        float s[8], self[8];
        u32x4 vv[16];
#pragma unroll
        for (int k = 0; k < 16; ++k) { vv[k] = (u32x4){0u, 0u, 0u, 0u}; if (k < cnt) vv[k] = *(const u32x4*)(XP + (size_t)(row - k) * 1024 + c0); }
        { const u32x4 v = vv[0];
          self[0] = bf_lo(v.x); self[1] = bf_hi(v.x); self[2] = bf_lo(v.y); self[3] = bf_hi(v.y); self[4] = bf_lo(v.z); self[5] = bf_hi(v.z); self[6] = bf_lo(v.w); self[7] = bf_hi(v.w); }
#pragma unroll
        for (int e = 0; e < 8; ++e) s[e] = self[e];
#pragma unroll
        for (int k = 1; k < 16; ++k) { const u32x4 v = vv[k];
            s[0] += bf_lo(v.x); s[1] += bf_hi(v.x); s[2] += bf_lo(v.y); s[3] += bf_hi(v.y); s[4] += bf_lo(v.z); s[5] += bf_hi(v.z); s[6] += bf_lo(v.w); s[7] += bf_hi(v.w); }
        const float ic = 1.0f / (float)cnt;
        u32x4 o; o.x = cvt_pk_bf16(s[0] * ic - self[0], s[1] * ic - self[1]); o.y = cvt_pk_bf16(s[2] * ic - self[2], s[3] * ic - self[3]);
        o.z = cvt_pk_bf16(s[4] * ic - self[4], s[5] * ic - self[5]); o.w = cvt_pk_bf16(s[6] * ic - self[6], s[7] * ic - self[7]);
        *(u32x4*)(ACAT + (size_t)row * 4096 + c0) = o;
    }
}

__device__ __forceinline__ void attn_phase(const bf16_t* Q, const bf16_t* Kb, const bf16_t* VT, const float* sinks, bf16_t* ACAT, int gw, int NGW, int iend, int lane) {
    const int r = lane & 31, hl = lane >> 5;
    for (int it = gw; it < iend; it += NGW) {
        const int qs = it & 3, g = (it >> 2) & 3, hkv = (it >> 4) & 3, n = (it >> 6) & 15, b = it >> 10;
        const int h = hkv * 4 + g, t0 = n * 128 + qs * 32;
        const size_t rowq = (size_t)b * SEQ + t0 + r;
        bf16x8 qf[4];
#pragma unroll
        for (int kk = 0; kk < 4; ++kk) qf[kk] = *(const bf16x8*)(Q + rowq * 1024 + h * 64 + kk * 16 + hl * 8);
        const float slope = exp2f(-0.5f * (float)(h + 1)), sink = sinks[h];
        float mx = sink, lsum = 0.f; f32x16 o[2];
#pragma unroll
        for (int e = 0; e < 16; ++e) { o[0][e] = 0.f; o[1][e] = 0.f; }
        const int kt_lo = t0 >= 128 ? 0 : 4 - (t0 >> 5);
#pragma nounroll
        for (int kt = kt_lo; kt < 5; ++kt) {
            const int ks = t0 - 128 + 32 * kt;
            f32x16 acc;
#pragma unroll
            for (int e = 0; e < 16; ++e) acc[e] = 0.f;
            const bf16_t* kp = Kb + ((size_t)b * SEQ + ks + r) * 256 + hkv * 64 + hl * 8;
            bf16x8 kf[4]; u32x4 vf[2][2];
#pragma unroll
            for (int kk = 0; kk < 4; ++kk) kf[kk] = *(const bf16x8*)(kp + kk * 16);
#pragma unroll
            for (int st = 0; st < 2; ++st)
#pragma unroll
                for (int dt = 0; dt < 2; ++dt) vf[st][dt] = *(const u32x4*)(VT + ((size_t)(b * 4 + hkv) * 64 + dt * 32 + r) * SEQ + ks + 16 * st + 8 * hl);
#pragma unroll
            for (int kk = 0; kk < 4; ++kk) acc = __builtin_amdgcn_mfma_f32_32x32x16_bf16(kf[kk], qf[kk], acc, 0, 0, 0);
            float tm = -__builtin_inff();
#pragma unroll
            for (int e = 0; e < 16; ++e) { const int keyrow = (e & 3) + 8 * (e >> 2) + 4 * hl; const int dist = 128 - 32 * kt + r - keyrow;
                const float v = (dist >= 0 && dist < 128) ? acc[e] * 0.125f - slope * (float)dist : -__builtin_inff();
                acc[e] = v; tm = fmaxf(tm, v); }
            tm = fmaxf(tm, __shfl_xor(tm, 32));
            const float mnew = fmaxf(mx, tm), alpha = __expf(mx - mnew);
            mx = mnew; lsum *= alpha;
#pragma unroll
            for (int e = 0; e < 16; ++e) { o[0][e] *= alpha; o[1][e] *= alpha; }
            float p[16];
#pragma unroll
            for (int e = 0; e < 16; ++e) { p[e] = __expf(acc[e] - mnew); lsum += p[e]; }
#pragma unroll
            for (int st = 0; st < 2; ++st) {
                u32x4 pw; pw.x = cvt_pk_bf16(p[8 * st + 0], p[8 * st + 1]); pw.y = cvt_pk_bf16(p[8 * st + 2], p[8 * st + 3]); pw.z = cvt_pk_bf16(p[8 * st + 4], p[8 * st + 5]); pw.w = cvt_pk_bf16(p[8 * st + 6], p[8 * st + 7]);
                const bf16x8 pb = __builtin_bit_cast(bf16x8, pw);
#pragma unroll
                for (int dt = 0; dt < 2; ++dt) o[dt] = __builtin_amdgcn_mfma_f32_32x32x16_bf16(__builtin_bit_cast(bf16x8, vf[st][dt]), pb, o[dt], 0, 0, 0);
            }
        }
        lsum += __shfl_xor(lsum, 32); lsum += __expf(sink - mx);
        const float inv = 1.0f / lsum;
#pragma unroll
        for (int dt = 0; dt < 2; ++dt)
#pragma unroll
            for (int i = 0; i < 4; ++i) { u32x2 w; w.x = cvt_pk_bf16(o[dt][4 * i] * inv, o[dt][4 * i + 1] * inv); w.y = cvt_pk_bf16(o[dt][4 * i + 2] * inv, o[dt][4 * i + 3] * inv);
                *(u32x2*)(ACAT + rowq * 4096 + 1024 + h * 64 + dt * 32 + 8 * i + 4 * hl) = w; }
    }
}

__device__ __forceinline__ void scan_phase(const bf16_t* DS, bf16_t* RB, int gtid, int NT) {
    for (int it = gtid; it < 16 * 512 * 32; it += NT) {
        const int dk8 = it & 31, dv = (it >> 5) & 511, bh = it >> 14, h = bh & 3;
        const float cd = exp2f(256.0f * ret_lg(h));
        u32x4 dw[7];
#pragma unroll
        for (int c = 0; c < 7; ++c) dw[c] = *(const u32x4*)(DS + ((size_t)(bh * 8 + c) * 512 + dv) * 256 + dk8 * 8);
        f32x4 s0 = (f32x4){0.f, 0.f, 0.f, 0.f}, s1 = s0;
#pragma unroll
        for (int c = 0; c < 7; ++c) {
            s0 = s0 * cd + (f32x4){bf_lo(dw[c].x), bf_hi(dw[c].x), bf_lo(dw[c].y), bf_hi(dw[c].y)}; s1 = s1 * cd + (f32x4){bf_lo(dw[c].z), bf_hi(dw[c].z), bf_lo(dw[c].w), bf_hi(dw[c].w)};
            u32x4 w; w.x = cvt_pk_bf16(s0[0], s0[1]); w.y = cvt_pk_bf16(s0[2], s0[3]); w.z = cvt_pk_bf16(s1[0], s1[1]); w.w = cvt_pk_bf16(s1[2], s1[3]);
            *(u32x4*)(RB + ((size_t)(bh * 8 + c + 1) * 512 + dv) * 512 + 256 + dk8 * 8) = w;
        }
    }
}

__global__ void __launch_bounds__(512, 2) fwd_megakernel(Args a_unused) {
    extern __shared__ __attribute__((aligned(16))) unsigned char lds_raw[];
    LAS unsigned char* lds = (LAS unsigned char*)lds_raw;
    ArgsP ap0 = (ArgsP)__builtin_amdgcn_kernarg_segment_ptr();
    const int ph_lo = ap0->ph_lo, ph_hi = ap0->ph_hi, coop = ap0->coop;
#if REP
    unsigned char* ws0 = ap0->ws;
#endif
    const int wave0 = __builtin_amdgcn_readfirstlane((int)threadIdx.x >> 6);
    volatile LAS unsigned* bar_st = (volatile LAS unsigned*)(lds + LDS_BYTES - 64);
    if (threadIdx.x == 0) { bar_st[0] = 0u; bar_st[1] = 0u; if (coop) (void)xb_add((unsigned*)(ap0->ws + WS_BAR) + XB_XCNT(xb_xcc_id()), 1u); }
    __syncthreads();
#if REP
    for (int step = 2 * ph_lo; step < 2 * ph_hi; ++step) {
    const int ph = step >> 1;
    if (step & 1) { const int pp = ph == 0 ? 0 : (ph - 1) % 13 + 1; bool again = false;
        if ((REP & 1) && (pp == 0 || (pp == 13 && ph < 14))) again = true;
        if ((REP & 4) && (pp == 1 || pp == 2 || pp == 11 || pp == 12)) again = true;
        if ((REP & 8) && pp == 4) again = true;
        if ((REP & 16) && pp == 5) again = true;
        if ((REP & 32) && pp == 6) again = true;
        if ((REP & 64) && pp == 7) again = true;
        if ((REP & 128) && pp == 8) again = true;
        if ((REP & 256) && pp == 9) again = true;
        if (REP & 2) { if (ph + 1 < ph_hi && coop) xcd_barrier((unsigned*)(ws0 + WS_BAR), bar_st); continue; }
        if (!again) continue; }
#else
    for (int ph = ph_lo; ph < ph_hi; ++ph) {
#endif
    if (ph != 0 && (ph - 1) % 13 + 1 == 6) continue;
    ArgsP ap = ap0; asm volatile("" : "+s"(ap));
    int tid; asm volatile("v_mbcnt_lo_u32_b32 %0, -1, 0\n\tv_mbcnt_hi_u32_b32 %0, -1, %0" : "=v"(tid)); tid += wave0 * 64;
    int G = gridDim.x, c = blockIdx.x; asm volatile("" : "+s"(G), "+s"(c));
    const int lane = tid & 63, wave = __builtin_amdgcn_readfirstlane(tid >> 6);
    const int gw = c * 8 + wave, NGW = G * 8, gtid = c * 512 + tid, NT = G * 512;
    int rp_gw = gw, rp_n = NGW, rp_end = MTOK;
    if (G == 256) { const int xq = c & 7, kq = c >> 3, bq = xq >> 1; rp_gw = bq * SEQ + ((xq & 1) * 32 + kq) * 8 + wave; rp_n = 512; rp_end = (bq + 1) * SEQ; }
    unsigned char* ws = ap->ws; asm volatile("" : "+s"(ws));
    bf16_t* HBF = (bf16_t*)(ws + WS_HBF); bf16_t* Y = (bf16_t*)(ws + WS_Y); float* SSQ = (float*)(ws + WS_SSQ); float* RINV = (float*)(ws + WS_RINV); float* SSQO = (float*)(ws + WS_SSQO);
    bf16_t* ACT = (bf16_t*)(ws + WS_ACT); bf16_t* Gt = (bf16_t*)(ws + WS_G); bf16_t* XP = (bf16_t*)(ws + WS_XP); bf16_t* Qb = (bf16_t*)(ws + WS_Q); bf16_t* KB = (bf16_t*)(ws + WS_KB);
    bf16_t* VT = (bf16_t*)(ws + WS_VT); bf16_t* RQ = (bf16_t*)(ws + WS_RQ); bf16_t* RK = (bf16_t*)(ws + WS_RK); bf16_t* RA = (bf16_t*)(ws + WS_RA); bf16_t* RKT = (bf16_t*)(ws + WS_RKT);
    bf16_t* RB = (bf16_t*)(ws + WS_RB); bf16_t* SG = (bf16_t*)(ws + WS_SG); bf16_t* DS = (bf16_t*)(ws + WS_DS); float* MF = (float*)(ws + WS_MF); bf16_t* ACAT = (bf16_t*)(ws + WS_ACAT); bf16_t* MB = (bf16_t*)(ws + WS_MB);
    float* H = ap->out;

        if (ph == 0) {
            prep_layer(ap, 0, lds, gw, NGW, wave, lane);
            rowpass(0, 0, ap->in[0], nullptr, nullptr, nullptr, 0.f, H, HBF, RINV, rp_gw, rp_n, rp_end, lane);
        } else {
            const int l = (ph - 1) / 13, p = (ph - 1) % 13 + 1;

            if (p == 1 || p == 11) {
                pg8::Gemm g{HBF, (const bf16_t*)(ws + (p == 1 ? WS_WUP1 : WS_WUP2)), DM, DM};
                pg8::SchedStd S{32, 44, G, c, DM, DM, 32};
                pg8::EpiSwiglu E{ACT, RINV};
                pg8::gemm_phase(lds, g, S, E, tid);
                if (p == 1) {
                    pg8::Gemm g2{(const bf16_t*)(ws + WS_WPOT), (const bf16_t*)(ws + WS_WPG), 1024, 256};
                    pg8::SchedPre S2{G, G - 1 - c};
                    pg8::EpiPre E2{(bf16_t*)(ws + WS_WCAT)};
                    pg8::gemm_phase(lds, g2, S2, E2, tid);
                }
            } else if (p == 2 || p == 12) {
                pg8::Gemm g{ACT, (const bf16_t*)(ws + (p == 2 ? WS_WDN1 : WS_WDN2)), FF, FF};
                pg8::SchedStd S{32, 8, G, c, FF, FF, 88};
                pg8::EpiYssq E{Y, SSQ};
                pg8::gemm_phase(lds, g, S, E, tid);
            } else if (p == 3 || p == 10 || p == 13) {
                const float* post = (p == 3 ? ap->in[4] : (p == 10 ? ap->in[16] : ap->in[20])) + l * DM;
#if REP
                if (!(step & 1))
#endif
                rowpass((l == 0 && p == 3) ? 1 : 2, (l == 1 && p == 13) ? 1 : 0, ap->in[0], Y, SSQ, post, p == 10 ? 1.0f : 0.5f, H, HBF, RINV, rp_gw, rp_n, rp_end, lane);
                if (p == 13 && l == 0) prep_layer(ap, 1, lds, gw, NGW, wave, lane);
            } else if (p == 4) {
                pg8::Gemm g{HBF, (const bf16_t*)(ws + WS_WIN), DM, DM};
                pg8::SchedStd S{32, 58, G, c, DM, DM, 32};
                pg8::EpiInproj E{RINV, XP, Qb, KB, VT, RQ, RK, RA, RKT, RB, SG, Gt};
                pg8::gemm_phase(lds, g, S, E, tid);
            } else if (p == 5) {
                if (c < 32) {
                    pg8::Gemm g{RB, RKT, 512, 1024}; pg8::SchedChain S{c}; pg8::EpiChain E{RB}; pg8::gemm_phase(lds, g, S, E, tid);
                } else {
                    const int G2 = G - 32, c2 = c - 32;
                    { pg8::Gemm g{RQ, RK, 1024, 1024}; pg8::SchedInner S{G2, c2}; pg8::EpiInner E{RA}; pg8::gemm_phase(lds, g, S, E, tid); }
                    if (G == 256) {
                        const int bq = (c & 7) >> 1, wq = (c & 1) * 28 + (c2 >> 3);
                        attn_phase(Qb, KB, VT, ap->in[9] + l * 16, ACAT, bq * 1024 + 447 - (wq * 8 + wave), 448, (bq + 1) * 1024, lane);
                        pool_phase(XP, ACAT, bq * (SEQ * 128) + wq * 512 + tid, 56 * 512, (bq + 1) * (SEQ * 128));
                    } else {
                        attn_phase(Qb, KB, VT, ap->in[9] + l * 16, ACAT, G2 * 8 - 1 - (c2 * 8 + wave), G2 * 8, 4096, lane);
                        pool_phase(XP, ACAT, c2 * 512 + tid, G2 * 512, MTOK * 128);
                    }
                }
            } else if (p == 7) {
                pg8::Gemm g{RA, RB, 2048, 512}; pg8::SchedO S{G, c}; pg8::EpiO E{ACAT, SG, SSQO}; pg8::gemm_phase(lds, g, S, E, tid);
            } else if (p == 8) {
                pg8::Gemm g{ACAT, (const bf16_t*)(ws + WS_WCAT), 4096, 4096}; pg8::SchedCat S{G, c}; pg8::EpiCat E{MB, Gt, SSQO}; pg8::gemm_phase(lds, g, S, E, tid);
            } else if (p == 9) {
                pg8::Gemm g{MB, (const bf16_t*)(ws + WS_WOUT), DM, DM};
                pg8::SchedStd S{32, 8, G, c, DM, DM, 32};
                pg8::EpiYssq E{Y, SSQ};
                pg8::gemm_phase(lds, g, S, E, tid);
            }
        }
#if REP
        if (ph + 1 < ph_hi || !(step & 1)) {
#else
        if (ph + 1 < ph_hi) {
#endif
            if (coop) { if (coop == 2) cg::this_grid().sync(); else xcd_barrier((unsigned*)(ws + WS_BAR), bar_st); }
        }
    }
}

extern "C" void kernel_launch(void* const* d_in, const int* in_sizes, int n_in, void* d_out, int out_size, void* d_ws, size_t ws_size, hipStream_t stream) {
    static int grid = 0;
    if (grid == 0) {
        if (n_in != 21 || out_size != MTOK * DM || ws_size < WS_END) { fprintf(stderr, "kernel_launch: unexpected shapes (n_in %d out %d ws %zu)\n", n_in, out_size, ws_size); grid = -1; return; }
        int dev = 0, cus = 0, per_cu = 0;
        hipGetDevice(&dev);
        hipDeviceGetAttribute(&cus, hipDeviceAttributeMultiprocessorCount, dev);
        if (hipFuncSetAttribute((const void*)fwd_megakernel, hipFuncAttributeMaxDynamicSharedMemorySize, LDS_BYTES) != hipSuccess) { fprintf(stderr, "kernel_launch: hipFuncSetAttribute failed\n"); grid = -1; return; }
        hipOccupancyMaxActiveBlocksPerMultiprocessor(&per_cu, (const void*)fwd_megakernel, 512, LDS_BYTES);
        (void)hipGetLastError();
        if (per_cu < 1) per_cu = 1;
        grid = cus * per_cu;
        if (grid > 256) grid = 256;
        fprintf(stderr, "kernel_launch: cus %d per_cu %d grid %d\n", cus, per_cu, grid);
    }
    if (grid < 0) return;
    Args a{};
    for (int i = 0; i < 21; ++i) a.in[i] = (const float*)d_in[i];
    a.out = (float*)d_out; a.ws = (unsigned char*)d_ws; a.pad = 0;
#if MK_COOP
    if (hipMemsetAsync((char*)d_ws + WS_BAR, 0, XCD_BAR_WORDS * 4, stream) != hipSuccess) { fprintf(stderr, "kernel_launch: memset failed\n"); return; }
    a.ph_lo = 0; a.ph_hi = NPHASE; a.coop = 1;
    void* args[] = {&a};
    hipError_t e = hipLaunchCooperativeKernel((const void*)fwd_megakernel, dim3(grid), dim3(512), args, LDS_BYTES, stream);
    if (e != hipSuccess) fprintf(stderr, "cooperative launch failed: %s (grid %d)\n", hipGetErrorString(e), grid);
#else
    a.coop = 0;
    for (int ph = 0; ph < NPHASE; ++ph) { a.ph_lo = ph; a.ph_hi = ph + 1; hipLaunchKernelGGL(fwd_megakernel, dim3(grid), dim3(512), LDS_BYTES, stream, a); }
#endif
}
```
